# Optimizing an MI355X kernel written in HIP

```python
import math
import jax, jax.numpy as jnp
from jax import lax
import numpy as np

D_MODEL = 1024
BATCH = 4
SEQ = 8192
DEPTH = 1

CHUNK = 64
NORM_EPS = 1e-5
SSM_WIDTH = D_MODEL // 2
SSM_GROUP = 16
SSM_GROUPS = SSM_WIDTH // SSM_GROUP
SSM_STATE = 64
DT_MIN = 1e-3
DT_MAX = 1e-1
SGU_WIDTH = D_MODEL // 2
SGU_BLOCK = 128
SGU_HEADS = 4
SGU_HEAD_DIM = SGU_WIDTH // SGU_HEADS
IN_WIDTH = SSM_WIDTH + 2 * SGU_WIDTH + 2 * D_MODEL
N_EXPERTS = 32
TOP_K = 4
D_EXPERT = D_MODEL
SWIGLU_ALPHA = 1.702
SWIGLU_LIMIT = 7.0
MOE_BLOCK = 512

kernel_name = "hybrid_s5_gmlp_moe_block"


def rmsnorm(x, g):
    xf = x.astype(jnp.float32)
    y = xf * lax.rsqrt(jnp.mean(xf * xf, axis=-1, keepdims=True) + NORM_EPS)
    return (y * g.astype(jnp.float32)).astype(x.dtype)


def layernorm(x, g, b):
    xf = x.astype(jnp.float32)
    mu = jnp.mean(xf, axis=-1, keepdims=True)
    xc = xf - mu
    y = xc * lax.rsqrt(jnp.mean(xc * xc, axis=-1, keepdims=True) + NORM_EPS)
    return (y * g.astype(jnp.float32) + b.astype(jnp.float32)).astype(x.dtype)


def s5_mixer(xa, lam_re, lam_im, log_dt, b_re, b_im, c_re, c_im, d_skip, w_glu, b_glu):
    bsz, seq, _ = xa.shape
    f32 = jnp.float32
    u = xa.astype(f32).reshape(bsz, seq, SSM_GROUPS, SSM_GROUP)
    lam = lax.complex(lam_re.astype(f32), lam_im.astype(f32))
    dt = jnp.exp(log_dt.astype(f32))[:, None]
    lam_bar = jnp.exp(lam * dt)
    b_bar = ((lam_bar - 1.0) / lam)[..., None] * lax.complex(b_re.astype(f32), b_im.astype(f32))
    bu = jnp.einsum('gnp,bsgp->bsgn', b_bar, u.astype(jnp.complex64))
    a = jnp.broadcast_to(lam_bar, (seq,) + lam_bar.shape)[None]

    def combine(left, right):
        a_l, b_l = left
        a_r, b_r = right
        return a_l * a_r, a_r * b_l + b_r

    _, states = lax.associative_scan(combine, (a, bu), axis=1)
    c = lax.complex(c_re.astype(f32), c_im.astype(f32))
    y = jnp.einsum('gpn,bsgn->bsgp', c, states).real + d_skip.astype(f32) * u
    y = y.reshape(bsz, seq, SSM_WIDTH)
    z = jax.nn.gelu(y)
    z = z * jax.nn.sigmoid(z @ w_glu.astype(f32) + b_glu.astype(f32))
    return z.astype(xa.dtype)


def sgu_mixer(xb, ln_g, ln_b, w_s, b_s):
    bsz, seq, _ = xb.shape
    z = jax.nn.gelu(xb)
    u, v = z[..., :SGU_WIDTH], z[..., SGU_WIDTH:]
    v = layernorm(v, ln_g, ln_b)
    n_blk = seq // SGU_BLOCK
    v = v.reshape(bsz, n_blk, SGU_BLOCK, SGU_HEADS, SGU_HEAD_DIM)
    chunk_id = jnp.arange(SGU_BLOCK) // CHUNK
    mask = chunk_id[:, None] >= chunk_id[None, :]
    w = jnp.where(mask[None], w_s, jnp.zeros_like(w_s))
    s = jnp.einsum('hij,bnjhc->bnihc', w, v) + b_s.T[:, :, None]
    return u * s.reshape(bsz, seq, SGU_WIDTH)


def moe(xn, w_router, b_router, w_gate, b_gate, w_up, b_up, w_down, b_down):
    bsz, seq, d = xn.shape
    t = bsz * seq
    xt = xn.reshape(t, d)
    logits = xt.astype(jnp.float32) @ w_router.astype(jnp.float32) + b_router.astype(jnp.float32)
    top_val, top_idx = lax.top_k(logits, TOP_K)
    gates = jax.nn.softmax(top_val, axis=-1)

    n_slots = t * TOP_K
    n_blocks = -(-n_slots // MOE_BLOCK) + N_EXPERTS
    n_rows = n_blocks * MOE_BLOCK
    flat_e = top_idx.reshape(-1)
    order = jnp.argsort(flat_e)
    sorted_e = flat_e[order]
    slot_token = (order // TOP_K).astype(jnp.int32)
    counts = jnp.bincount(flat_e, length=N_EXPERTS)
    padded = (counts + MOE_BLOCK - 1) // MOE_BLOCK * MOE_BLOCK
    start = jnp.cumsum(counts) - counts
    pstart = jnp.cumsum(padded) - padded
    dest = pstart[sorted_e] + jnp.arange(n_slots) - start[sorted_e]
    row_token = jnp.full((n_rows,), t, jnp.int32).at[dest].set(slot_token)
    row_gate = jnp.zeros((n_rows,), jnp.float32).at[dest].set(gates.reshape(-1)[order])
    block_expert = jnp.minimum(
        jnp.searchsorted(jnp.cumsum(padded), jnp.arange(n_blocks) * MOE_BLOCK, side='right'),
        N_EXPERTS - 1)
    x_pad = jnp.concatenate([xt, jnp.zeros((1, d), xt.dtype)], axis=0)
    x_rows = x_pad[row_token].reshape(n_blocks, MOE_BLOCK, d)

    def expert_block(args):
        xb, e = args
        g = xb @ w_gate[e] + b_gate[e]
        l = xb @ w_up[e] + b_up[e]
        g = jnp.minimum(g, SWIGLU_LIMIT)
        l = jnp.clip(l, -SWIGLU_LIMIT, SWIGLU_LIMIT)
        h = g * jax.nn.sigmoid(SWIGLU_ALPHA * g) * (l + 1.0)
        return h @ w_down[e] + b_down[e]

    y_rows = lax.map(expert_block, (x_rows, block_expert)).reshape(n_rows, d)
    y_rows = y_rows * row_gate[:, None].astype(y_rows.dtype)
    y = jax.ops.segment_sum(y_rows, row_token, num_segments=t + 1)[:t]
    return y.reshape(bsz, seq, d)


def setup_inputs(seed: int = 0) -> dict:
    key = jax.random.key(seed)
    ks = jax.random.split(key, 32)
    f32 = jnp.float32
    L, D, G, N, P = DEPTH, D_MODEL, SSM_GROUPS, SSM_STATE, SSM_GROUP
    nrm = lambda k, shape, s: jax.random.normal(k, shape, f32) * s
    gain = lambda k, shape: 1.0 + 0.02 * jax.random.normal(k, shape, f32)
    n_idx = jnp.arange(N, dtype=f32)
    return {
        "x": jax.random.normal(ks[0], (BATCH, SEQ, D), f32),
        "norm_mix_g": gain(ks[1], (L, D)),
        "w_in": nrm(ks[2], (L, D, IN_WIDTH), D ** -0.5),
        "lam_re": -0.5 + nrm(ks[3], (L, G, N), 0.01),
        "lam_im": math.pi * n_idx + nrm(ks[4], (L, G, N), 0.01),
        "log_dt": jax.random.uniform(ks[5], (L, G), f32, math.log(DT_MIN), math.log(DT_MAX)),
        "b_re": nrm(ks[6], (L, G, N, P), (2 * P) ** -0.5),
        "b_im": nrm(ks[7], (L, G, N, P), (2 * P) ** -0.5),
        "c_re": nrm(ks[8], (L, G, P, N), N ** -0.5),
        "c_im": nrm(ks[9], (L, G, P, N), N ** -0.5),
        "d_skip": nrm(ks[10], (L, G, P), 1.0),
        "w_glu": nrm(ks[11], (L, SSM_WIDTH, SSM_WIDTH), SSM_WIDTH ** -0.5),
        "b_glu": nrm(ks[12], (L, SSM_WIDTH), 0.01),
        "sgu_ln_g": gain(ks[13], (L, SGU_WIDTH)),
        "sgu_ln_b": nrm(ks[14], (L, SGU_WIDTH), 0.01),
        "w_s": nrm(ks[15], (L, SGU_HEADS, SGU_BLOCK, SGU_BLOCK), SGU_BLOCK ** -0.5),
        "b_s": gain(ks[16], (L, SGU_HEADS, SGU_BLOCK)),
        "w_branch_a": nrm(ks[17], (L, SSM_WIDTH, D), SSM_WIDTH ** -0.5),
        "w_branch_b": nrm(ks[18], (L, SGU_WIDTH, D), SGU_WIDTH ** -0.5),
        "w_out": nrm(ks[19], (L, D, D), D ** -0.5),
        "norm_moe_g": gain(ks[20], (L, D)),
        "w_router": nrm(ks[21], (L, D, N_EXPERTS), D ** -0.5),
        "b_router": nrm(ks[22], (L, N_EXPERTS), 0.01),
        "w_gate": nrm(ks[23], (L, N_EXPERTS, D, D_EXPERT), D ** -0.5),
        "b_gate": nrm(ks[24], (L, N_EXPERTS, D_EXPERT), 0.01),
        "w_up": nrm(ks[25], (L, N_EXPERTS, D, D_EXPERT), D ** -0.5),
        "b_up": nrm(ks[26], (L, N_EXPERTS, D_EXPERT), 0.01),
        "w_down": nrm(ks[27], (L, N_EXPERTS, D_EXPERT, D), D_EXPERT ** -0.5),
        "b_down": nrm(ks[28], (L, N_EXPERTS, D), 0.01),
        "norm_final_g": gain(ks[29], (D,)),
    }


def reference(x, norm_mix_g, w_in, lam_re, lam_im, log_dt, b_re, b_im, c_re, c_im, d_skip,
              w_glu, b_glu, sgu_ln_g, sgu_ln_b, w_s, b_s, w_branch_a, w_branch_b, w_out,
              norm_moe_g, w_router, b_router, w_gate, b_gate, w_up, b_up, w_down, b_down,
              norm_final_g):
    h = x
    s_a = SSM_WIDTH
    s_b = s_a + 2 * SGU_WIDTH
    s_g = s_b + D_MODEL
    for layer in range(DEPTH):
        xn = rmsnorm(h, norm_mix_g[layer])
        proj = xn @ w_in[layer]
        xa, xb = proj[..., :s_a], proj[..., s_a:s_b]
        ga, gb = proj[..., s_b:s_g], proj[..., s_g:]
        ya = s5_mixer(xa, lam_re[layer], lam_im[layer], log_dt[layer], b_re[layer], b_im[layer],
                      c_re[layer], c_im[layer], d_skip[layer], w_glu[layer], b_glu[layer])
        yb = sgu_mixer(xb, sgu_ln_g[layer], sgu_ln_b[layer], w_s[layer], b_s[layer])
        merged = (jax.nn.sigmoid(ga) * (ya @ w_branch_a[layer])
                  + jax.nn.sigmoid(gb) * (yb @ w_branch_b[layer]))
        h = h + merged @ w_out[layer]
        h = h + moe(rmsnorm(h, norm_moe_g[layer]), w_router[layer], b_router[layer],
                    w_gate[layer], b_gate[layer], w_up[layer], b_up[layer],
                    w_down[layer], b_down[layer])
    return rmsnorm(h, norm_final_g)
```

```cpp
#include <hip/hip_runtime.h>
#include <cstdio>
#include <cstdint>

#ifndef MK_N_LAUNCHES
#define MK_N_LAUNCHES 1
#endif

#define LAS __attribute__((address_space(3)))
#define GAS __attribute__((address_space(1)))
typedef unsigned short bf16_t;
typedef short bf16x8 __attribute__((ext_vector_type(8)));
typedef float f32x4 __attribute__((ext_vector_type(4)));
typedef float f32x2 __attribute__((ext_vector_type(2)));
typedef float f32x16 __attribute__((ext_vector_type(16)));
typedef unsigned u32x4 __attribute__((ext_vector_type(4)));
typedef unsigned u32x2 __attribute__((ext_vector_type(2)));
typedef short s16x4 __attribute__((ext_vector_type(4)));
typedef GAS unsigned gu32;

constexpr int T = 32768, D = 1024, INW = 3584, NE = 32;
constexpr int AS5_LD = 384;
constexpr float NORM_EPS = 1e-5f;
constexpr int NWAVES = 8, NTHREADS = 512;
constexpr int NPHASE = 13;

constexpr size_t MiB = 1u << 20, KiB = 1024;
constexpr size_t WS_CTL = 0, CTL_ZERO_BYTES = 64 * KiB;
constexpr size_t WS_RS1 = 1 * MiB, WS_RS2 = WS_RS1 + 128 * KiB;
constexpr size_t WS_TOPE = WS_RS2 + 128 * KiB, WS_TOPG = WS_TOPE + 512 * KiB, WS_SPOS = WS_TOPG + 512 * KiB, WS_SROW = WS_SPOS + 512 * KiB;
constexpr int NROWS_CAP = 131072 + 512;
constexpr size_t WS_RTOK = WS_SROW + 512 * KiB, WS_RGATE = WS_RTOK + 640 * KiB, WS_RRS = WS_RGATE + 640 * KiB;
constexpr size_t WS_LAM = WS_RRS + 640 * KiB;
static_assert(WS_LAM + 64 * KiB <= 8 * MiB, "tables");
constexpr size_t WS_WDT = 8 * MiB;
constexpr size_t WS_H1B = 72 * MiB;
constexpr size_t WS_Y = 136 * MiB;
constexpr size_t WS_W1T = 136 * MiB;
constexpr size_t WS_AS5 = 264 * MiB;
constexpr size_t WS_U = 312 * MiB, WS_V = 344 * MiB;
constexpr size_t WS_WINT = 376 * MiB, WS_W1S = 383 * MiB, WS_MT = 387 * MiB;
constexpr size_t WS_HWS = 393 * MiB;
constexpr size_t WS_SST = 393 * MiB, WS_YB = 425 * MiB, WS_MRG = 457 * MiB;
constexpr size_t WS_SMALL = 522 * MiB;
constexpr size_t WS_WGLUT = WS_SMALL, WS_WAT = WS_WGLUT + 512 * KiB, WS_WBT = WS_WAT + 1 * MiB, WS_WOT = WS_WBT + 1 * MiB, WS_WM = WS_WOT + 2 * MiB;
constexpr size_t WS_END = 527 * MiB;
static_assert(WS_WM + 128 * KiB <= WS_END && WS_MRG + 64 * MiB <= WS_SMALL && WS_Y + 257 * MiB <= WS_HWS && WS_MT + 6 * MiB <= WS_HWS, "ws map");
constexpr int HSPLIT = 65536;
constexpr int CW_BAR = 4096, CW_CNT = 8192;

constexpr int LDS_BYTES = 155648;
constexpr int LDS_X = 131072;
constexpr int LDS_MISC = LDS_BYTES - 256;

#define LDS_WAIT() asm volatile("s_waitcnt lgkmcnt(0)" ::: "memory")
#define VM_WAIT() asm volatile("s_waitcnt vmcnt(0)" ::: "memory")
#define RLX_AGENT __ATOMIC_RELAXED, __HIP_MEMORY_SCOPE_AGENT
__device__ __forceinline__ unsigned cvt_pk_bf16(float lo, float hi) { unsigned r; asm volatile("v_cvt_pk_bf16_f32 %0, %1, %2" : "=v"(r) : "v"(lo), "v"(hi)); return r; }
__device__ __forceinline__ float bflo(unsigned w) { return __builtin_bit_cast(float, w << 16); }
__device__ __forceinline__ float bfhi(unsigned w) { return __builtin_bit_cast(float, w & 0xffff0000u); }
__device__ __forceinline__ float sigmoid_f(float x) { return __builtin_amdgcn_rcpf(1.0f + __builtin_amdgcn_exp2f(-1.4426950408889634f * x)); }
__device__ __forceinline__ float gelu_f(float x) {
    const float u = x * (1.0f + 0.044715f * x * x);
    return x * __builtin_amdgcn_rcpf(1.0f + __builtin_amdgcn_exp2f(-2.302208198f * u));
}
__device__ __forceinline__ float wave_sum(float v) {
#pragma unroll
    for (int o = 1; o < 64; o <<= 1) v += __shfl_xor(v, o);
    return v;
}
__device__ __forceinline__ u32x4 pack8(f32x4 a, f32x4 b) { u32x4 w; w.x = cvt_pk_bf16(a[0], a[1]); w.y = cvt_pk_bf16(a[2], a[3]); w.z = cvt_pk_bf16(b[0], b[1]); w.w = cvt_pk_bf16(b[2], b[3]); return w; }
__device__ __forceinline__ void unpack8(u32x4 w, f32x4& a, f32x4& b) { a = (f32x4){bflo(w.x), bfhi(w.x), bflo(w.y), bfhi(w.y)}; b = (f32x4){bflo(w.z), bfhi(w.z), bflo(w.w), bfhi(w.w)}; }

#define XB_TMO      128
#define XB_XCNT(j)  (256  + 64 * (j))
#define XB_XSUB(j)  (1280 + 64 * (j))
#define XB_XGEN(j)  (2304 + 64 * (j))
#define XB_TOP      3328
#define XB_TOPGEN   3392
#define XCD_BAR_WORDS 3456
#define XB_SPIN_CAP (1u << 20)
__device__ __forceinline__ unsigned xb_ld(unsigned* p)              { return __hip_atomic_load(p, __ATOMIC_RELAXED, __HIP_MEMORY_SCOPE_AGENT); }
__device__ __forceinline__ unsigned xb_add(unsigned* p, unsigned v) { return __hip_atomic_fetch_add(p, v, __ATOMIC_RELAXED, __HIP_MEMORY_SCOPE_AGENT); }
__device__ __forceinline__ unsigned xb_xcc_id() { return (unsigned)__builtin_amdgcn_s_getreg((3 << 11) | 20) & 0xFu; }
#define XB_SPIN(cond, bar) do { unsigned _sp = 0; while (cond) { __builtin_amdgcn_s_sleep(1); \
    if ((++_sp & 255u) == 0u) { if (xb_ld(&(bar)[XB_TMO])) break; if (_sp > XB_SPIN_CAP) { atomicAdd(&(bar)[XB_TMO], 1u); break; } } } } while (0)
struct XcdBarrier { unsigned* bar; unsigned x; volatile LAS unsigned* st; };
__device__ __forceinline__ XcdBarrier xcd_barrier_post(unsigned* bar, volatile LAS unsigned* st) {
    XcdBarrier b; b.bar = bar; b.x = xb_xcc_id(); b.st = st;
    if (threadIdx.x == 0) (void)xb_add(&bar[XB_XCNT(b.x)], 1u);
    return b;
}
__device__ __forceinline__ void xcd_barrier_complete(unsigned* bar, unsigned x, unsigned& nloc, unsigned& nx) {
    const unsigned G = gridDim.x * gridDim.y * gridDim.z;
    unsigned sum, cnt, mine, sp = 0u;
    for (;;) {
        sum = 0u; cnt = 0u; mine = 0u;
#pragma unroll
        for (unsigned j = 0; j < 16; ++j) { const unsigned c = xb_ld(&bar[XB_XCNT(j)]); sum += c; cnt += (c > 0u) ? 1u : 0u; mine = (j == x) ? c : mine; }
        if (sum == G) break;
        __builtin_amdgcn_s_sleep(1);
        if ((++sp & 255u) == 0u) { if (xb_ld(&bar[XB_TMO])) break; if (sp > XB_SPIN_CAP) { atomicAdd(&bar[XB_TMO], 1u); break; } }
    }
    nloc = mine > 0u ? mine : 1u; nx = cnt > 0u ? cnt : 1u;
}
__device__ __forceinline__ void xcd_barrier(const XcdBarrier& b) {
    asm volatile("s_waitcnt vmcnt(0)" ::: "memory");
    __syncthreads();
    if (threadIdx.x == 0) {
        unsigned* bar = b.bar;
        __builtin_amdgcn_s_waitcnt(0);
        unsigned nloc = b.st[0], nx = b.st[1];
        if (nloc == 0u) { xcd_barrier_complete(bar, b.x, nloc, nx); b.st[0] = nloc; b.st[1] = nx; }
        const unsigned old = xb_add(&bar[XB_XSUB(b.x)], 1u);
        const unsigned gen = old / nloc;
        if (old + 1u == (gen + 1u) * nloc) {
            __builtin_amdgcn_fence(__ATOMIC_RELEASE, "agent");
            asm volatile("s_waitcnt vmcnt(0)" ::: "memory");
            const unsigned og = xb_add(&bar[XB_TOP], 1u);
            const unsigned tg = og / nx;
            if (og + 1u == (tg + 1u) * nx) xb_add(&bar[XB_TOPGEN], 1u);
            else XB_SPIN(xb_ld(&bar[XB_TOPGEN]) == tg, bar);
            __builtin_amdgcn_fence(__ATOMIC_ACQUIRE, "agent");
            xb_add(&bar[XB_XGEN(b.x)], 1u);
            asm volatile("s_waitcnt vmcnt(0)" ::: "memory");
        } else {
            XB_SPIN(xb_ld(&bar[XB_XGEN(b.x)]) == gen, bar);
            __builtin_amdgcn_fence(__ATOMIC_ACQUIRE, "agent");
            asm volatile("s_waitcnt vmcnt(0)" ::: "memory");
        }
    }
    __syncthreads();
}

namespace pg8 {
constexpr int BM = 256, BK = 64, HALF = 128, HTB = HALF * BK * 2, STAGE_BYTES = 8 * HTB, NXCD = 8, WGM = 8;
__host__ __device__ __forceinline__ int lds_byte(int r, int c) { const int st = (r >> 4) * 2 + (c >> 5), rr = r & 15, cc = c & 31, ob = rr * 64 + cc * 2; return st * 1024 + (ob ^ (((ob >> 9) & 1) << 5)); }
__host__ __device__ __forceinline__ void stage_rc(int b, int& R, int& C) { const int st = b / 1024, sb = b % 1024, swz = sb ^ (((sb >> 9) & 1) << 5); R = (st >> 1) * 16 + swz / 64; C = (st & 1) * 32 + (swz % 64) / 2; }
__host__ __device__ __forceinline__ int perm32(int rho) { const int n = rho >> 4, i = rho & 15; return 8 * (i >> 2) + 4 * n + (i & 3); }

struct Unit { const char* a; const char* b; int pm, pn, x0, x1; };
__device__ __forceinline__ void tile_order(int L, int nM, int nN, int& pm, int& pn) {
    const int nwg = nM * nN; int wgid = L; { const int q = nwg / NXCD, r = nwg % NXCD, xcd = wgid % NXCD, off = wgid / NXCD; wgid = (xcd < r ? xcd * (q + 1) : r * (q + 1) + (xcd - r) * q) + off; }
    const int nig = WGM * nN, gid = wgid / nig, fm = gid * WGM, gsz = (nM - fm) < WGM ? (nM - fm) : WGM;
    pm = fm + ((wgid % nig) % gsz); pn = (wgid % nig) / gsz;
}

template <class Epi, class Sched>
__device__ __forceinline__ void gemm_phase(LAS unsigned char* lds, const Sched& S, const Epi& E) {
    constexpr bool GATHER = Sched::GATHER;
    int tid_ = threadIdx.x; asm volatile("" : "+v"(tid_));
    const int tid = tid_, wid = __builtin_amdgcn_readfirstlane(tid >> 6), lane = tid & 63, wr = wid >> 2, wc = wid & 3, fr = lane & 15, fq = lane >> 4;
    const int nt = S.nt; const unsigned K2 = S.K2, hstepB = 128u * K2, hstepA = S.hstepA;
    unsigned voffA[2], voffB[2];
#pragma unroll
    for (int i = 0; i < 2; ++i) { int R, C; stage_rc(tid * 16 + i * 8192, R, C); const int Rb = (R & ~31) + perm32(R & 31);
        voffA[i] = (unsigned)R * S.lda2 + (unsigned)C * 2u; voffB[i] = (unsigned)Rb * K2 + (unsigned)C * 2u; }
    const unsigned ldsw = (unsigned)wid * 1024u;
    const int aoff = lds_byte(wr * 64 + fr, fq * 8), boff = lds_byte(wc * 32 + fr, fq * 8);
#define PG8_SA(b, h) (((b) * 2 + (h)) * HTB)
#define PG8_SB(b, h) ((4 + (b) * 2 + (h)) * HTB)
#define PG8_GLDS(gp, lo) __builtin_amdgcn_global_load_lds((const unsigned*)(gp), (LAS unsigned*)(lds + (lo)), 16, 0, 0)
#define PG8_STAGE_B(bufoff, gbase) do { _Pragma("unroll") for (int _i = 0; _i < 2; ++_i) PG8_GLDS((const char*)(gbase) + voffB[_i], (bufoff) + ldsw + _i * 8192); } while (0)
#define PG8_STAGE_A(bufoff, gbase, h, VO) do { _Pragma("unroll") for (int _i = 0; _i < 2; ++_i) { \
        if constexpr (GATHER) PG8_GLDS((const char*)(gbase) + VO[h][_i], (bufoff) + ldsw + _i * 8192); \
        else PG8_GLDS((const char*)(gbase) + (size_t)((h) * hstepA) + voffA[_i], (bufoff) + ldsw + _i * 8192); } } while (0)
#define PG8_LDA(dst, b, h) do { _Pragma("unroll") for (int m = 0; m < 4; ++m) _Pragma("unroll") for (int k = 0; k < 2; ++k) dst[m][k] = *(const LAS bf16x8*)(lds + PG8_SA(b, h) + aoff + m * 2048 + k * 1024); } while (0)
#define PG8_LDB(dst, b, h) do { _Pragma("unroll") for (int n = 0; n < 2; ++n) _Pragma("unroll") for (int k = 0; k < 2; ++k) dst[n][k] = *(const LAS bf16x8*)(lds + PG8_SB(b, h) + boff + n * 2048 + k * 1024); } while (0)
#define PG8_MMA(ai, bj, At, Bt) do { __builtin_amdgcn_s_setprio(1); _Pragma("unroll") for (int m = 0; m < 4; ++m) _Pragma("unroll") for (int n = 0; n < 2; ++n) _Pragma("unroll") for (int k = 0; k < 2; ++k) \
        acc[ai][bj][m][n] = __builtin_amdgcn_mfma_f32_16x16x32_bf16(Bt[n][k], At[m][k], acc[ai][bj][m][n], 0, 0, 0); __builtin_amdgcn_s_setprio(0); } while (0)
#define PG8_WAIT_V(n) asm volatile("s_waitcnt vmcnt(" #n ")" ::: "memory")
#define PG8_WAIT_L(n) asm volatile("s_waitcnt lgkmcnt(" #n ")" ::: "memory")
#define PG8_BAR __builtin_amdgcn_s_barrier()
#define PG8_SCHED __builtin_amdgcn_sched_barrier(0)
    Unit cur, nxt; int ui = 0;
    if (!S.next(0, cur)) return;
    unsigned cvo[2][2], nvo[2][2];
    if constexpr (GATHER) S.aoffs(cur, cvo); else { cvo[0][0] = cvo[0][1] = cvo[1][0] = cvo[1][1] = 0u; }
    f32x4 acc[2][2][4][2];
#pragma unroll
    for (int a = 0; a < 2; ++a)
#pragma unroll
        for (int b = 0; b < 2; ++b)
#pragma unroll
            for (int m = 0; m < 4; ++m)
#pragma unroll
                for (int n = 0; n < 2; ++n) acc[a][b][m][n] = (f32x4){0.f, 0.f, 0.f, 0.f};
    bf16x8 At[4][2], B0[2][2], B1[2][2];
    const char* cA = cur.a; const char* cB = cur.b;
    PG8_STAGE_B(PG8_SB(0, 0), cB); PG8_STAGE_B(PG8_SB(0, 1), cB + hstepB); PG8_STAGE_A(PG8_SA(0, 0), cA, 0, cvo); PG8_STAGE_A(PG8_SA(0, 1), cA, 1, cvo);
    if (wr == 1) PG8_BAR;
    PG8_WAIT_V(2); PG8_BAR;
    PG8_STAGE_B(PG8_SB(1, 0), cB + 128); PG8_STAGE_A(PG8_SA(1, 0), cA + 128, 0, cvo); PG8_STAGE_B(PG8_SB(1, 1), cB + hstepB + 128);
    PG8_WAIT_V(6); PG8_BAR;
    for (;;) {
        const bool has_next = S.next(ui + 1, nxt);
        if constexpr (GATHER) { if (has_next) S.aoffs(nxt, nvo); else { nvo[0][0] = cvo[0][0]; nvo[0][1] = cvo[0][1]; nvo[1][0] = cvo[1][0]; nvo[1][1] = cvo[1][1]; } }
        const char* nA = has_next ? nxt.a : cA; const char* nB = has_next ? nxt.b : cB;
        for (int t = 0; t < nt; t += 2) {
            const bool last = (t == nt - 2);
            const char* a1 = cA + (size_t)(t + 1) * 128;
            const char* a2 = last ? nA : cA + (size_t)(t + 2) * 128; const char* b2 = last ? nB : cB + (size_t)(t + 2) * 128;
            const char* a3 = a2 + 128; const char* b3 = b2 + 128;
            unsigned v2[2][2];
            if constexpr (GATHER) { v2[0][0] = last ? nvo[0][0] : cvo[0][0]; v2[0][1] = last ? nvo[0][1] : cvo[0][1]; v2[1][0] = last ? nvo[1][0] : cvo[1][0]; v2[1][1] = last ? nvo[1][1] : cvo[1][1]; }
            else { v2[0][0] = v2[0][1] = v2[1][0] = v2[1][1] = 0u; }
            PG8_LDB(B0, 0, 0); PG8_LDB(B1, 0, 1); PG8_SCHED; PG8_LDA(At, 0, 0); PG8_STAGE_A(PG8_SA(1, 1), a1, 1, cvo);
            PG8_WAIT_V(8); PG8_WAIT_L(0); PG8_BAR; PG8_MMA(0, 0, At, B0); PG8_MMA(0, 1, At, B1); PG8_BAR; PG8_SCHED;
            PG8_LDA(At, 0, 1); PG8_STAGE_B(PG8_SB(0, 0), b2); PG8_STAGE_B(PG8_SB(0, 1), b2 + hstepB); PG8_STAGE_A(PG8_SA(0, 0), a2, 0, v2);
            PG8_WAIT_V(8); PG8_WAIT_L(0); PG8_BAR; PG8_MMA(1, 0, At, B0); PG8_MMA(1, 1, At, B1); PG8_BAR; PG8_SCHED;
            PG8_LDB(B0, 1, 0); PG8_LDB(B1, 1, 1); PG8_SCHED; PG8_LDA(At, 1, 0); PG8_STAGE_A(PG8_SA(0, 1), a2, 1, v2);
            PG8_WAIT_V(8); PG8_WAIT_L(0); PG8_BAR; PG8_MMA(0, 0, At, B0); PG8_MMA(0, 1, At, B1); PG8_BAR; PG8_SCHED;
            PG8_LDA(At, 1, 1); PG8_STAGE_B(PG8_SB(1, 0), b3); PG8_STAGE_B(PG8_SB(1, 1), b3 + hstepB); PG8_STAGE_A(PG8_SA(1, 0), a3, 0, v2);
            PG8_WAIT_V(8); PG8_WAIT_L(0); PG8_BAR; PG8_MMA(1, 0, At, B0); PG8_MMA(1, 1, At, B1); PG8_BAR; PG8_SCHED;
        }
        if (wr == 0) PG8_BAR;
        E(acc, cur, wr, wc, fr, fq);
        if (!has_next) break;
#pragma unroll
        for (int a = 0; a < 2; ++a)
#pragma unroll
            for (int b = 0; b < 2; ++b)
#pragma unroll
                for (int m = 0; m < 4; ++m)
#pragma unroll
                    for (int n = 0; n < 2; ++n) acc[a][b][m][n] = (f32x4){0.f, 0.f, 0.f, 0.f};
        cur = nxt; cA = nA; cB = nB; ++ui;
        if constexpr (GATHER) { cvo[0][0] = nvo[0][0]; cvo[0][1] = nvo[0][1]; cvo[1][0] = nvo[1][0]; cvo[1][1] = nvo[1][1]; }
        if (wr == 1) PG8_BAR;
    }
    PG8_WAIT_V(0);
    PG8_BAR;
#undef PG8_SA
#undef PG8_SB
#undef PG8_GLDS
#undef PG8_STAGE_A
#undef PG8_STAGE_B
#undef PG8_LDA
#undef PG8_LDB
#undef PG8_MMA
#undef PG8_WAIT_V
#undef PG8_WAIT_L
#undef PG8_BAR
#undef PG8_SCHED
}

struct DenseSched {
    static constexpr bool GATHER = false;
    const char* A; const char* Bt; unsigned lda2, K2, hstepA; int nt, nM, nN, nwg, G, c;
    __device__ __forceinline__ void init(const void* A_, const void* Bt_, int M, int N, int K, int lda, int G_, int c_) {
        A = (const char*)A_; Bt = (const char*)Bt_; lda2 = (unsigned)lda * 2u; K2 = (unsigned)K * 2u; hstepA = 128u * lda2; nt = K / 64; nM = M / 256; nN = N / 256; nwg = nM * nN; G = G_; c = c_; }
    __device__ __forceinline__ bool next(int i, Unit& u) const {
        const long L = (long)i * G + c; if (L >= nwg) return false;
        tile_order((int)L, nM, nN, u.pm, u.pn);
        u.a = A + (size_t)u.pm * 256 * lda2; u.b = Bt + (size_t)u.pn * 256 * K2; u.x0 = 0; u.x1 = 0; return true; }
    __device__ __forceinline__ void aoffs(const Unit&, unsigned (&)[2][2]) const {}
};
struct S5Sched {
    static constexpr bool GATHER = false;
    const char* A; const char* Bt; unsigned lda2, K2, hstepA; int nt, id;
    __device__ __forceinline__ void init(const void* A_, const void* Bt_, int K, int id_) { A = (const char*)A_; Bt = (const char*)Bt_; lda2 = AS5_LD * 2; K2 = (unsigned)K * 2u; hstepA = 128u * lda2; nt = K / 64; id = id_; }
    __device__ __forceinline__ bool next(int i, Unit& u) const {
        if (i > 0 || id >= 256) return false;
        const int g = id >> 3; u.pm = id & 7; u.pn = 0; u.x0 = g; u.x1 = 0;
        u.a = A + ((size_t)g * 2048 + (size_t)u.pm * 256) * lda2; u.b = Bt + (size_t)g * 256 * K2; return true; }
    __device__ __forceinline__ void aoffs(const Unit&, unsigned (&)[2][2]) const {}
};
struct MergeSched {
    static constexpr bool GATHER = false;
    const char* A0; const char* A1; const char* B0; const char* B1; unsigned lda2, K2, hstepA; int nt, nM, nN, nwg, G, c;
    __device__ __forceinline__ void init(const void* a0, const void* a1, const void* b0, const void* b1, int G_, int c_) {
        A0 = (const char*)a0; A1 = (const char*)a1; B0 = (const char*)b0; B1 = (const char*)b1; lda2 = 1024u; K2 = 1024u; hstepA = 128u * lda2; nt = 8; nM = T / 256; nN = 4; nwg = nM * nN; G = G_; c = c_; }
    __device__ __forceinline__ bool next(int i, Unit& u) const {
        const long L = (long)(i >> 1) * G + c; if (L >= nwg) return false;
        tile_order((int)L, nM, nN, u.pm, u.pn); const int pass = i & 1;
        u.a = (pass ? A1 : A0) + (size_t)u.pm * 256 * lda2; u.b = (pass ? B1 : B0) + (size_t)u.pn * 256 * K2; u.x0 = pass; u.x1 = 0; return true; }
    __device__ __forceinline__ void aoffs(const Unit&, unsigned (&)[2][2]) const {}
};
struct MoeSched1 {
    static constexpr bool GATHER = true;
    const char* A; const char* Bt; const int* rtk; const LAS int* tt; unsigned lda2, K2, hstepA; int nt, ntiles, G, vc;
    __device__ __forceinline__ bool next(int i, Unit& u) const {
        const int L = i * G + vc; const int tile = L >> 3; if (tile >= ntiles) return false;
        const int w0 = __builtin_amdgcn_readfirstlane(tt[2 * tile]), row0 = __builtin_amdgcn_readfirstlane(tt[2 * tile + 1]);
        const int e = w0 & 255; u.pm = tile; u.pn = L & 7; u.x0 = row0; u.x1 = w0;
        u.a = A; u.b = Bt + ((size_t)e * 2048 + (size_t)u.pn * 256) * K2; return true; }
    __device__ __forceinline__ void aoffs(const Unit& u, unsigned (&vo)[2][2]) const {
        const int nrows = u.x1 >> 8; int Rr[2], Cc[2];
        { int t_ = threadIdx.x; asm volatile("" : "+v"(t_));
#pragma unroll
        for (int i = 0; i < 2; ++i) stage_rc(t_ * 16 + i * 8192, Rr[i], Cc[i]); }
#pragma unroll
        for (int h = 0; h < 2; ++h)
#pragma unroll
            for (int i = 0; i < 2; ++i) { const int rl = h * 128 + Rr[i]; const int tok = rl < nrows ? rtk[u.x0 + rl] : 0; vo[h][i] = (unsigned)tok * 2048u + (unsigned)Cc[i] * 2u; }
    }
};
struct MoeSched2 {
    static constexpr bool GATHER = false;
    const char* Alo; const char* Ahi; const char* Bt; const LAS int* tt; unsigned lda2, K2, hstepA; int nt, ntiles, G, vc;
    __device__ __forceinline__ bool next(int i, Unit& u) const {
        const int L = i * G + vc; const int tile = L >> 2; if (tile >= ntiles) return false;
        const int w0 = __builtin_amdgcn_readfirstlane(tt[2 * tile]), row0 = __builtin_amdgcn_readfirstlane(tt[2 * tile + 1]);
        const int e = w0 & 255; u.pm = tile; u.pn = L & 3; u.x0 = row0; u.x1 = w0;
        u.a = (row0 < HSPLIT ? Alo + (size_t)row0 * 2048 : Ahi + (size_t)(row0 - HSPLIT) * 2048); u.b = Bt + ((size_t)e * 1024 + (size_t)u.pn * 256) * K2; return true; }
    __device__ __forceinline__ void aoffs(const Unit&, unsigned (&)[2][2]) const {}
};

#define EPI_ARGS const f32x4 (&acc)[2][2][4][2], const Unit& u, int wr, int wc, int fr, int fq
struct EpiInProj {
    const float* rs1; bf16_t *AS5, *U, *V, *GA, *GB;
    __device__ __forceinline__ void operator()(EPI_ARGS) const {
        const int row0 = u.pm * 256 + wr * 64 + fr, colw = wc * 32 + 8 * fq, pn = u.pn;
        const int mode = pn < 2 ? 0 : (pn < 6 ? 1 : 2);
#pragma unroll
        for (int ai = 0; ai < 2; ++ai)
#pragma unroll
            for (int m = 0; m < 4; ++m) { const int row = row0 + ai * 128 + m * 16; const float rs = rs1[row];
#pragma unroll
                for (int bj = 0; bj < 2; ++bj) { const int c = pn * 256 + bj * 128 + colw; f32x4 v0 = acc[ai][bj][m][0] * rs, v1 = acc[ai][bj][m][1] * rs; bf16_t* dst;
                    if (mode == 0) { dst = AS5 + ((size_t)((c >> 4) * 2048 + (row >> 4)) * AS5_LD + (row & 15) * 16 + (c & 15)); }
                    else if (mode == 1) {
#pragma unroll
                        for (int j = 0; j < 4; ++j) { v0[j] = gelu_f(v0[j]); v1[j] = gelu_f(v1[j]); }
                        dst = (pn < 4 ? U + (size_t)row * 512 + (c - 512) : V + (size_t)row * 512 + (c - 1024)); }
                    else {
#pragma unroll
                        for (int j = 0; j < 4; ++j) { v0[j] = sigmoid_f(v0[j]); v1[j] = sigmoid_f(v1[j]); }
                        dst = (pn < 10 ? GA + (size_t)row * 1024 + (c - 1536) : GB + (size_t)row * 1024 + (c - 2560)); }
                    *(u32x4*)dst = pack8(v0, v1); } }
    }
};
struct EpiS5End {
    float* SST;
    __device__ __forceinline__ void operator()(EPI_ARGS) const {
        const int row0 = u.pm * 256 + wr * 64 + fr, colw = wc * 32 + 8 * fq, g = u.x0;
#pragma unroll
        for (int ai = 0; ai < 2; ++ai)
#pragma unroll
            for (int m = 0; m < 4; ++m) { const int row = row0 + ai * 128 + m * 16; float* dst = SST + (size_t)row * 4096 + g * 128 + colw;
                *(f32x4*)dst = acc[ai][0][m][0]; *(f32x4*)(dst + 4) = acc[ai][0][m][1]; }
    }
};
struct EpiS5Out {
    bf16_t* Z;
    __device__ __forceinline__ void operator()(EPI_ARGS) const {
        const int row0 = u.pm * 256 + wr * 64 + fr, colw = wc * 32 + 8 * fq, g = u.x0;
#pragma unroll
        for (int ai = 0; ai < 2; ++ai)
#pragma unroll
            for (int m = 0; m < 4; ++m) { const int row = row0 + ai * 128 + m * 16;
#pragma unroll
                for (int bj = 0; bj < 2; ++bj) { const int c = bj * 128 + colw; f32x4 v0 = acc[ai][bj][m][0], v1 = acc[ai][bj][m][1];
#pragma unroll
                    for (int j = 0; j < 4; ++j) { v0[j] = gelu_f(v0[j]); v1[j] = gelu_f(v1[j]); }
                    *(u32x4*)(Z + ((size_t)row * 16 + (c >> 4)) * 512 + g * 16 + (c & 15)) = pack8(v0, v1); } }
    }
};
struct EpiGlu {
    const bf16_t* Z; const float* bglu; bf16_t* YA;
    __device__ __forceinline__ void operator()(EPI_ARGS) const {
        const int row0 = u.pm * 256 + wr * 64 + fr, colw = wc * 32 + 8 * fq;
#pragma unroll
        for (int bj = 0; bj < 2; ++bj) { const int c = u.pn * 256 + bj * 128 + colw; const f32x4 b0 = *(const f32x4*)(bglu + c), b1 = *(const f32x4*)(bglu + c + 4);
#pragma unroll
            for (int ai = 0; ai < 2; ++ai)
#pragma unroll
                for (int m = 0; m < 4; ++m) { const int row = row0 + ai * 128 + m * 16; const size_t off = (size_t)row * 512 + c;
                    f32x4 z0, z1; unpack8(*(const u32x4*)(Z + off), z0, z1); f32x4 v0 = acc[ai][bj][m][0] + b0, v1 = acc[ai][bj][m][1] + b1;
#pragma unroll
                    for (int j = 0; j < 4; ++j) { v0[j] = z0[j] * sigmoid_f(v0[j]); v1[j] = z1[j] * sigmoid_f(v1[j]); }
                    *(u32x4*)(YA + off) = pack8(v0, v1); } }
    }
};
struct EpiMerge {
    const bf16_t *GA, *GB; bf16_t* MRG;
    __device__ __forceinline__ void operator()(EPI_ARGS) const {
        const int row0 = u.pm * 256 + wr * 64 + fr, colw = wc * 32 + 8 * fq; const int pass = u.x0; const bf16_t* Gp = pass ? GB : GA;
#pragma unroll
        for (int ai = 0; ai < 2; ++ai)
#pragma unroll
            for (int m = 0; m < 4; ++m) { const int row = row0 + ai * 128 + m * 16;
#pragma unroll
                for (int bj = 0; bj < 2; ++bj) { const size_t off = (size_t)row * 1024 + u.pn * 256 + bj * 128 + colw;
                    f32x4 g0, g1; unpack8(*(const u32x4*)(Gp + off), g0, g1); f32x4 v0 = acc[ai][bj][m][0] * g0, v1 = acc[ai][bj][m][1] * g1;
                    if (pass) { f32x4 p0, p1; unpack8(*(const u32x4*)(MRG + off), p0, p1); v0 += p0; v1 += p1; }
                    *(u32x4*)(MRG + off) = pack8(v0, v1); } }
    }
};
struct EpiOutProj {
    const float* x; float* H1; bf16_t* H1b;
    __device__ __forceinline__ void operator()(EPI_ARGS) const {
        const int row0 = u.pm * 256 + wr * 64 + fr, colw = wc * 32 + 8 * fq;
#pragma unroll
        for (int ai = 0; ai < 2; ++ai)
#pragma unroll
            for (int m = 0; m < 4; ++m) { const int row = row0 + ai * 128 + m * 16;
#pragma unroll
                for (int bj = 0; bj < 2; ++bj) { const size_t off = (size_t)row * 1024 + u.pn * 256 + bj * 128 + colw;
                    const f32x4 v0 = acc[ai][bj][m][0] + *(const f32x4*)(x + off), v1 = acc[ai][bj][m][1] + *(const f32x4*)(x + off + 4);
                    *(f32x4*)(H1 + off) = v0; *(f32x4*)(H1 + off + 4) = v1; *(u32x4*)(H1b + off) = pack8(v0, v1); } }
    }
};
struct EpiMoe1 {
    const float *rrs, *bgate, *bup; bf16_t *Hlo, *Hhi;
    __device__ __forceinline__ void operator()(EPI_ARGS) const {
        const int rl0 = wr * 64 + fr, colw = wc * 32 + 8 * fq, row0 = u.x0, nrows = u.x1 >> 8, e = u.x1 & 255; const int c = u.pn * 128 + colw;
        const f32x4 bg0 = *(const f32x4*)(bgate + e * 1024 + c), bg1 = *(const f32x4*)(bgate + e * 1024 + c + 4), bu0 = *(const f32x4*)(bup + e * 1024 + c), bu1 = *(const f32x4*)(bup + e * 1024 + c + 4);
        bf16_t* Hb = row0 < HSPLIT ? Hlo + (size_t)row0 * 1024 : Hhi + (size_t)(row0 - HSPLIT) * 1024;
#pragma unroll
        for (int ai = 0; ai < 2; ++ai)
#pragma unroll
            for (int m = 0; m < 4; ++m) { const int rl = rl0 + ai * 128 + m * 16;
                if (rl < nrows) { const float rs = rrs[row0 + rl];
                    f32x4 g0 = acc[ai][0][m][0] * rs + bg0, g1 = acc[ai][0][m][1] * rs + bg1, l0 = acc[ai][1][m][0] * rs + bu0, l1 = acc[ai][1][m][1] * rs + bu1;
#pragma unroll
                    for (int j = 0; j < 4; ++j) { float g = fminf(g0[j], 7.0f), l = fminf(fmaxf(l0[j], -7.0f), 7.0f); g0[j] = g * sigmoid_f(1.702f * g) * (l + 1.0f);
                        g = fminf(g1[j], 7.0f); l = fminf(fmaxf(l1[j], -7.0f), 7.0f); g1[j] = g * sigmoid_f(1.702f * g) * (l + 1.0f); }
                    *(u32x4*)(Hb + (size_t)rl * 1024 + c) = pack8(g0, g1); } }
    }
};
struct EpiMoe2 {
    const float *rgate, *bdown; bf16_t* Y;
    __device__ __forceinline__ void operator()(EPI_ARGS) const {
        const int rl0 = wr * 64 + fr, colw = wc * 32 + 8 * fq, row0 = u.x0, nrows = u.x1 >> 8, e = u.x1 & 255;
#pragma unroll
        for (int bj = 0; bj < 2; ++bj) { const int c = u.pn * 256 + bj * 128 + colw; const f32x4 b0 = *(const f32x4*)(bdown + e * 1024 + c), b1 = *(const f32x4*)(bdown + e * 1024 + c + 4);
#pragma unroll
            for (int ai = 0; ai < 2; ++ai)
#pragma unroll
                for (int m = 0; m < 4; ++m) { const int rl = rl0 + ai * 128 + m * 16;
                    if (rl < nrows) { const float gt = rgate[row0 + rl];
                        *(u32x4*)(Y + (size_t)(row0 + rl) * 1024 + c) = pack8((acc[ai][bj][m][0] + b0) * gt, (acc[ai][bj][m][1] + b1) * gt); } } }
    }
};
}

struct RowId { __device__ __forceinline__ int operator()(int n) const { return n; } };
struct RowGU { int add; __device__ __forceinline__ int operator()(int n) const { return (n >> 7) * 256 + (n & 127) + add; } };
template <class RM>
__device__ __forceinline__ void transpose_item(const float* W, int ldw, const float* ks, bf16_t* WT, int ldt, RM rm, LAS float* scr, int k0, int n0, int lane) {
#pragma unroll 8
    for (int i = 0; i < 32; ++i) { const int kk = 2 * i + (lane >> 5); float w = W[(size_t)(k0 + kk) * ldw + n0 + (lane & 31)]; if (ks) w *= ks[k0 + kk]; scr[kk * 33 + (lane & 31)] = w; }
    LDS_WAIT(); asm volatile("" ::: "memory");
    const int c = lane & 7;
#pragma unroll
    for (int j = 0; j < 4; ++j) { const int n = (lane >> 3) + 8 * j; const LAS float* s = scr + (8 * c) * 33 + n;
        u32x4 o; o.x = cvt_pk_bf16(s[0 * 33], s[1 * 33]); o.y = cvt_pk_bf16(s[2 * 33], s[3 * 33]); o.z = cvt_pk_bf16(s[4 * 33], s[5 * 33]); o.w = cvt_pk_bf16(s[6 * 33], s[7 * 33]);
        *(u32x4*)(WT + (size_t)rm(n0 + n) * ldt + k0 + 8 * c) = o; }
    LDS_WAIT(); asm volatile("" ::: "memory");
}

struct Args { const float* in[30]; float* out; unsigned char* ws; int ph_lo, ph_hi; };
__device__ __forceinline__ const float* in_ptr_(int byte_off) { const float* p; asm volatile("s_load_dwordx2 %0, %1, %2\n\ts_waitcnt lgkmcnt(0)" : "=s"(p) : "s"(__builtin_amdgcn_kernarg_segment_ptr()), "i"(byte_off)); return p; }
#define INP(k) in_ptr_((k) * 8)


__device__ __forceinline__ void s5_build_group(const Args& args, int g, LAS unsigned char* lds, int tid) {
    const float *lam_re = INP(3), *lam_im = INP(4), *log_dt = INP(5), *b_re = INP(6), *b_im = INP(7), *c_re = INP(8), *c_im = INP(9), *d_skip = INP(10);
    LAS f32x2* pw = (LAS f32x2*)lds;
    LAS f32x2* bb = pw + 17 * 64;
    LAS f32x2* Cg = bb + 64 * 16;
    LAS float* Kt = (LAS float*)(Cg + 16 * 64);
    bf16_t* W1s = (bf16_t*)(args.ws + WS_W1S) + (size_t)g * 256 * 256;
    bf16_t* MT = (bf16_t*)(args.ws + WS_MT) + (size_t)g * 256 * 384;
    f32x2* lamtab = (f32x2*)(args.ws + WS_LAM);
    if (tid < 64) {
        const int n = tid; const float lr = lam_re[g * 64 + n], li = lam_im[g * 64 + n], dt = expf(log_dt[g]);
        for (int m = 0; m <= 16; ++m) { const float mag = expf(lr * dt * (float)m); float sn, cs; sincosf(li * dt * (float)m, &sn, &cs); pw[m * 64 + n] = (f32x2){mag * cs, mag * sn}; }
        { const float mag = expf(lr * dt * 16.0f); float sn, cs; sincosf(li * dt * 16.0f, &sn, &cs); lamtab[g * 64 + n] = (f32x2){mag * cs, mag * sn}; }
        { const float mag = expf(lr * dt * 512.0f); float sn, cs; sincosf(li * dt * 512.0f, &sn, &cs); lamtab[2048 + g * 64 + n] = (f32x2){mag * cs, mag * sn}; }
        const f32x2 lb = pw[64 + n]; const float nr = lb.x - 1.0f, ni = lb.y, den = 1.0f / (lr * lr + li * li);
        const float cr = (nr * lr + ni * li) * den, ci = (ni * lr - nr * li) * den;
        for (int q = 0; q < 16; ++q) { const float br = b_re[(g * 64 + n) * 16 + q], bi = b_im[(g * 64 + n) * 16 + q]; bb[n * 16 + q] = (f32x2){cr * br - ci * bi, cr * bi + ci * br}; }
    }
    for (int i = tid; i < 1024; i += NTHREADS) Cg[i] = (f32x2){c_re[g * 1024 + i], c_im[g * 1024 + i]};
    __syncthreads();
    for (int i = tid; i < 4096; i += NTHREADS) { const int tau = i >> 8, p = (i >> 4) & 15, q = i & 15; float s = 0.f;
        for (int n = 0; n < 64; ++n) { const f32x2 c = Cg[p * 64 + n], w = pw[tau * 64 + n], b = bb[n * 16 + q];
            const float xr = c.x * w.x - c.y * w.y, xi = c.x * w.y + c.y * w.x; s += xr * b.x - xi * b.y; }
        if (tau == 0 && p == q) s += d_skip[g * 16 + p];
        Kt[i] = s; }
    __syncthreads();
    for (int i = tid; i < 256 * 48; i += NTHREADS) { const int row = i / 48, ch = i % 48, t = row >> 4, p = row & 15, k0 = ch * 8; float v[8];
        if (k0 < 256) { const int j = k0 >> 4, q0 = k0 & 15;
#pragma unroll
            for (int e = 0; e < 8; ++e) v[e] = (j <= t) ? Kt[((t - j) * 16 + p) * 16 + q0 + e] : 0.f; }
        else {
#pragma unroll
            for (int e = 0; e < 8; ++e) { const int sidx = k0 - 256 + e, n = sidx & 63; const f32x2 c = Cg[p * 64 + n], w = pw[(t + 1) * 64 + n];
                v[e] = (sidx < 64) ? (c.x * w.x - c.y * w.y) : -(c.x * w.y + c.y * w.x); } }
        u32x4 o; o.x = cvt_pk_bf16(v[0], v[1]); o.y = cvt_pk_bf16(v[2], v[3]); o.z = cvt_pk_bf16(v[4], v[5]); o.w = cvt_pk_bf16(v[6], v[7]);
        *(u32x4*)(MT + (size_t)row * 384 + k0) = o; }
    for (int i = tid; i < 256 * 32; i += NTHREADS) { const int row = i >> 5, k0 = (i & 31) * 8, j = k0 >> 4, q0 = k0 & 15; float v[8];
#pragma unroll
        for (int e = 0; e < 8; ++e) { if (row < 128) { const int n = row & 63; const f32x2 w = pw[(15 - j) * 64 + n], b = bb[n * 16 + q0 + e];
                v[e] = (row < 64) ? (w.x * b.x - w.y * b.y) : (w.x * b.y + w.y * b.x); } else v[e] = 0.f; }
        u32x4 o; o.x = cvt_pk_bf16(v[0], v[1]); o.y = cvt_pk_bf16(v[2], v[3]); o.z = cvt_pk_bf16(v[4], v[5]); o.w = cvt_pk_bf16(v[6], v[7]);
        *(u32x4*)(W1s + (size_t)row * 256 + k0) = o; }
    __syncthreads();
}

__device__ __forceinline__ int moe_build_tiles(gu32* counts, LAS int* tt, int tid) {
    LAS int* cnt = tt + 1400; LAS int* st = cnt + 32; LAS int* tb = st + 33;
    if (tid < 32) cnt[tid] = (int)__hip_atomic_load(counts + tid, RLX_AGENT);
    __syncthreads();
    if (tid == 0) { int s = 0, b = 0;
        for (int e = 0; e < 32; ++e) { const int n = cnt[e]; if (s < HSPLIT && s + n > HSPLIT) s += (HSPLIT - s) & 255; st[e] = s; tb[e] = b; s += n; b += (n + 255) >> 8; }
        st[32] = s; tb[32] = b; }
    __syncthreads();
    if (tid < 32) { const int n = cnt[tid], s = st[tid], b = tb[tid]; const int k = (n + 255) >> 8;
        for (int m = 0; m < k; ++m) { const int nr = (n - m * 256) < 256 ? (n - m * 256) : 256; tt[2 * (b + m)] = tid | (nr << 8); tt[2 * (b + m) + 1] = s + m * 256; } }
    __syncthreads();
    return tb[32];
}

template <int PHM>
__global__ void __launch_bounds__(NTHREADS, 2) mk_fwd(Args args) {
    extern __shared__ __attribute__((aligned(16))) unsigned char lds_raw[];
    LAS unsigned char* lds = (LAS unsigned char*)lds_raw;
    volatile LAS unsigned* MISC = (volatile LAS unsigned*)(lds + LDS_MISC);
    const int tid = threadIdx.x, lane = tid & 63, wave = __builtin_amdgcn_readfirstlane(tid >> 6);
    const int G = gridDim.x; const int bx = blockIdx.x; const int vcu = (G % 8 == 0) ? (bx % 8) * (G / 8) + bx / 8 : bx;
    unsigned char* ws = args.ws;
#define ctl ((gu32*)(ws + WS_CTL))
    if (tid < 64) MISC[tid] = 0u;
    __syncthreads();
    if (MK_N_LAUNCHES == 1) (void)xcd_barrier_post((unsigned*)(ws + WS_CTL) + CW_BAR, (volatile LAS unsigned*)(lds + LDS_MISC) + 8);
#define GRID_BAR() do { if (MK_N_LAUNCHES == 1) { XcdBarrier bar_; bar_.bar = (unsigned*)(ws + WS_CTL) + CW_BAR; bar_.x = xb_xcc_id(); bar_.st = (volatile LAS unsigned*)(lds + LDS_MISC) + 8; xcd_barrier(bar_); } } while (0)
#define IN(k) ((PHM >> (k)) & 1)
#define Xin ((const float*)INP(0))
#define rs1 ((float*)(ws + WS_RS1))
#define rs2 ((float*)(ws + WS_RS2))
#define tope ((int*)(ws + WS_TOPE))
#define topg ((float*)(ws + WS_TOPG))
#define spos ((int*)(ws + WS_SPOS))
#define srow ((int*)(ws + WS_SROW))
#define rtok ((int*)(ws + WS_RTOK))
#define rgate ((float*)(ws + WS_RGATE))
#define rrs ((float*)(ws + WS_RRS))
#define XB ((bf16_t*)(ws + WS_H1B))
#define H1b ((bf16_t*)(ws + WS_H1B))
#define WinT ((bf16_t*)(ws + WS_WINT))
#define WgluT ((bf16_t*)(ws + WS_WGLUT))
#define WaT ((bf16_t*)(ws + WS_WAT))
#define WbT ((bf16_t*)(ws + WS_WBT))
#define WoT ((bf16_t*)(ws + WS_WOT))
#define W1T ((bf16_t*)(ws + WS_W1T))
#define WdT ((bf16_t*)(ws + WS_WDT))
#define Wm ((bf16_t*)(ws + WS_WM))
#define AS5 ((bf16_t*)(ws + WS_AS5))
#define Ub ((bf16_t*)(ws + WS_U))
#define Vb ((bf16_t*)(ws + WS_V))
#define Zb ((bf16_t*)(ws + WS_U))
#define YA ((bf16_t*)(ws + WS_V))
#define GA ((bf16_t*)args.out)
#define GB ((bf16_t*)args.out + (size_t)T * 1024)
#define SST ((float*)(ws + WS_SST))
#define YB ((bf16_t*)(ws + WS_YB))
#define MRG ((bf16_t*)(ws + WS_MRG))
#define H1 ((float*)args.out)
#define Hlo ((bf16_t*)args.out)
#define Hhi ((bf16_t*)(ws + WS_HWS))
#define Yb ((bf16_t*)(ws + WS_Y))
#define gw (vcu * NWAVES + wave)
#define NGW (G * NWAVES)

    if (IN(0)) {
        LAS float* scr = (LAS float*)(lds + wave * 16384);
        if (vcu < 32) s5_build_group(args, vcu, lds, tid);
        for (int m = gw; m < T; m += NGW) { const f32x4* xr = (const f32x4*)(Xin + (size_t)m * D) + lane; f32x4 v[4]; float s = 0.f;
#pragma unroll
            for (int j = 0; j < 4; ++j) { v[j] = xr[64 * j]; s += (v[j].x * v[j].x + v[j].y * v[j].y) + (v[j].z * v[j].z + v[j].w * v[j].w); }
            s = wave_sum(s); if (lane == 0) rs1[m] = 1.0f / sqrtf(s * (1.0f / D) + NORM_EPS);
            u32x2* o = (u32x2*)(XB + (size_t)m * D) + lane;
#pragma unroll
            for (int j = 0; j < 4; ++j) { u32x2 w; w.x = cvt_pk_bf16(v[j].x, v[j].y); w.y = cvt_pk_bf16(v[j].z, v[j].w); o[64 * j] = w; } }
        constexpr int I_IN = 16 * 112, I_GLU = 8 * 16, I_A = 8 * 32, I_B = 8 * 32, I_O = 16 * 32, I_E = 16 * 32, I_MOE = 96 * I_E;
        constexpr int NITEMS = I_IN + I_GLU + I_A + I_B + I_O + I_MOE;
        for (int it = gw; it < NITEMS; it += NGW) { int r = it;
            if (r < I_IN) { transpose_item(INP(2), INW, INP(1), WinT, 1024, RowId{}, scr, (r / 112) * 64, (r % 112) * 32, lane); continue; } r -= I_IN;
            if (r < I_GLU) { transpose_item(INP(11), 512, nullptr, WgluT, 512, RowId{}, scr, (r / 16) * 64, (r % 16) * 32, lane); continue; } r -= I_GLU;
            if (r < I_A) { transpose_item(INP(17), 1024, nullptr, WaT, 512, RowId{}, scr, (r / 32) * 64, (r % 32) * 32, lane); continue; } r -= I_A;
            if (r < I_B) { transpose_item(INP(18), 1024, nullptr, WbT, 512, RowId{}, scr, (r / 32) * 64, (r % 32) * 32, lane); continue; } r -= I_B;
            if (r < I_O) { transpose_item(INP(19), 1024, nullptr, WoT, 1024, RowId{}, scr, (r / 32) * 64, (r % 32) * 32, lane); continue; } r -= I_O;
            const int ty = r / (32 * I_E), e = (r / I_E) % 32, q = r % I_E, k0 = (q / 32) * 64, n0 = (q % 32) * 32;
            if (ty == 0) transpose_item(INP(23) + (size_t)e * 1048576, 1024, INP(20), W1T + (size_t)e * 2048 * 1024, 1024, RowGU{0}, scr, k0, n0, lane);
            else if (ty == 1) transpose_item(INP(25) + (size_t)e * 1048576, 1024, INP(20), W1T + (size_t)e * 2048 * 1024, 1024, RowGU{128}, scr, k0, n0, lane);
            else transpose_item(INP(27) + (size_t)e * 1048576, 1024, nullptr, WdT + (size_t)e * 1024 * 1024, 1024, RowId{}, scr, k0, n0, lane);
        }
        for (int i = vcu * NTHREADS + tid; i < 4 * 128 * 128; i += G * NTHREADS) { const int ii = (i >> 7) & 127, jj = i & 127; const float w = ((ii >> 6) >= (jj >> 6)) ? INP(15)[i] : 0.f; Wm[i] = (bf16_t)(cvt_pk_bf16(w, 0.f) & 0xffffu); }
        GRID_BAR();
    }

    if (IN(1)) {
        pg8::DenseSched S; S.init(XB, WinT, T, INW, D, D, G, bx);
        pg8::EpiInProj E{rs1, AS5, Ub, Vb, GA, GB};
        pg8::gemm_phase(lds, S, E);
        GRID_BAR();
    }

    if (IN(2)) {
        { pg8::S5Sched S; S.init(AS5, ws + WS_W1S, 256, vcu); pg8::EpiS5End E{SST}; pg8::gemm_phase(lds, S, E); }
        for (int item = vcu; item < 256; item += G) {
            const int t0 = item * 128; constexpr int RS = 1056;
            const float* lng = INP(13); const float* lnb = INP(14); const float* bs = INP(16);
            f32x4 g0 = *(const f32x4*)(lng + lane * 8), g1 = *(const f32x4*)(lng + lane * 8 + 4), b0 = *(const f32x4*)(lnb + lane * 8), b1 = *(const f32x4*)(lnb + lane * 8 + 4);
            for (int r = 0; r < 16; ++r) { const int j = wave * 16 + r; f32x4 v0, v1; unpack8(*(const u32x4*)(Vb + (size_t)(t0 + j) * 512 + lane * 8), v0, v1);
                float s = (v0[0] + v0[1]) + (v0[2] + v0[3]) + (v1[0] + v1[1]) + (v1[2] + v1[3]); const float mean = wave_sum(s) * (1.0f / 512.0f);
                v0 -= mean; v1 -= mean; float q = (v0[0] * v0[0] + v0[1] * v0[1]) + (v0[2] * v0[2] + v0[3] * v0[3]) + (v1[0] * v1[0] + v1[1] * v1[1]) + (v1[2] * v1[2] + v1[3] * v1[3]);
                const float rstd = 1.0f / sqrtf(wave_sum(q) * (1.0f / 512.0f) + NORM_EPS);
                v0 = v0 * rstd * g0 + b0; v1 = v1 * rstd * g1 + b1;
                *(LAS u32x4*)(lds + j * RS + lane * 16) = pack8(v0, v1); }
            __syncthreads();
            const int i0 = wave * 16, fr = lane & 15, fq = lane >> 4;
            for (int h = 0; h < 4; ++h) {
                bf16x8 wf[4];
#pragma unroll
                for (int ks = 0; ks < 4; ++ks) wf[ks] = *(const bf16x8*)(Wm + ((size_t)h * 128 + i0 + fr) * 128 + ks * 32 + fq * 8);
                const float bias = bs[h * 128 + i0 + fr];
#pragma unroll
                for (int cb = 0; cb < 8; ++cb) { f32x4 a = (f32x4){0.f, 0.f, 0.f, 0.f}; const int c0 = h * 128 + cb * 16;
#pragma unroll
                    for (int ks = 0; ks < 4; ++ks) {
                        const LAS unsigned char* p = lds + (ks * 32 + fq * 8 + (fr >> 2)) * RS + (c0 + 4 * (fr & 3)) * 2;
                        const s16x4 lo4 = __builtin_bit_cast(s16x4, __builtin_amdgcn_ds_read_tr16_b64_v4i16((LAS s16x4*)p));
                        const s16x4 hi4 = __builtin_bit_cast(s16x4, __builtin_amdgcn_ds_read_tr16_b64_v4i16((LAS s16x4*)(p + 4 * RS)));
                        const bf16x8 vf = (bf16x8){lo4[0], lo4[1], lo4[2], lo4[3], hi4[0], hi4[1], hi4[2], hi4[3]};
                        a = __builtin_amdgcn_mfma_f32_16x16x32_bf16(vf, wf[ks], a, 0, 0, 0); }
                    const size_t off = (size_t)(t0 + i0 + fr) * 512 + c0 + 4 * fq; const u32x2 uw = *(const u32x2*)(Ub + off);
                    u32x2 o; o.x = cvt_pk_bf16(bflo(uw.x) * (a[0] + bias), bfhi(uw.x) * (a[1] + bias)); o.y = cvt_pk_bf16(bflo(uw.y) * (a[2] + bias), bfhi(uw.y) * (a[3] + bias));
                    *(u32x2*)(YB + off) = o; } }
            __syncthreads();
        }
        GRID_BAR();
    }

    if (IN(3)) {
        for (int item = vcu; item < 256; item += G) {
            const int b = item >> 6, g = (item >> 1) & 31, nh = item & 1;
            LAS float* sm = (LAS float*)lds;
            LAS f32x2* Eb = (LAS f32x2*)(lds + 131072);
            for (int i = tid; i < 8192; i += NTHREADS) { const int c = i >> 4, part = (i >> 3) & 1, q = i & 7;
                *(LAS f32x4*)(sm + c * 64 + part * 32 + q * 4) = *(const f32x4*)(SST + (size_t)(b * 512 + c) * 4096 + g * 128 + part * 64 + nh * 32 + q * 4); }
            __syncthreads();
            const int seg = tid >> 5, nl = tid & 31, n = nh * 32 + nl; const f32x2* lamtab = (const f32x2*)(ws + WS_LAM);
            const f32x2 l16 = lamtab[g * 64 + n], l512 = lamtab[2048 + g * 64 + n];
            float sr = 0.f, si = 0.f;
            for (int c = seg * 32; c < seg * 32 + 32; ++c) { const float xr = sm[c * 64 + nl], xi = sm[c * 64 + 32 + nl]; const float tr = l16.x * sr - l16.y * si + xr, ti = l16.x * si + l16.y * sr + xi; sr = tr; si = ti; }
            Eb[seg * 32 + nl] = (f32x2){sr, si};
            __syncthreads();
            sr = 0.f; si = 0.f;
            for (int s = 0; s < seg; ++s) { const f32x2 e = Eb[s * 32 + nl]; const float tr = l512.x * sr - l512.y * si + e.x, ti = l512.x * si + l512.y * sr + e.y; sr = tr; si = ti; }
            bf16_t* dst = AS5 + ((size_t)g * 2048 + (size_t)b * 512) * AS5_LD + 256 + n;
            for (int c = seg * 32; c < seg * 32 + 32; ++c) {
                dst[(size_t)c * AS5_LD] = (bf16_t)(cvt_pk_bf16(sr, 0.f) & 0xffffu); dst[(size_t)c * AS5_LD + 64] = (bf16_t)(cvt_pk_bf16(si, 0.f) & 0xffffu);
                const float xr = sm[c * 64 + nl], xi = sm[c * 64 + 32 + nl]; const float tr = l16.x * sr - l16.y * si + xr, ti = l16.x * si + l16.y * sr + xi; sr = tr; si = ti; }
            __syncthreads();
        }
        GRID_BAR();
    }

    if (IN(4)) {
        pg8::S5Sched S; S.init(AS5, ws + WS_MT, 384, vcu); pg8::EpiS5Out E{Zb}; pg8::gemm_phase(lds, S, E);
        GRID_BAR();
    }
    if (IN(5)) {
        pg8::DenseSched S; S.init(Zb, WgluT, T, 512, 512, 512, G, bx); pg8::EpiGlu E{Zb, INP(12), YA}; pg8::gemm_phase(lds, S, E);
        GRID_BAR();
    }
    if (IN(6)) {
        pg8::MergeSched S; S.init(YA, YB, WaT, WbT, G, bx); pg8::EpiMerge E{GA, GB, MRG}; pg8::gemm_phase(lds, S, E);
        GRID_BAR();
    }
    if (IN(7)) {
        pg8::DenseSched S; S.init(MRG, WoT, T, D, D, D, G, bx); pg8::EpiOutProj E{Xin, H1, H1b}; pg8::gemm_phase(lds, S, E);
        GRID_BAR();
    }
    if (IN(8)) {
        LAS float* WR = (LAS float*)lds;
        LAS int* hist = (LAS int*)(lds + LDS_X + 20480); LAS int* hbase = hist + 32;
        const float* wr_ = INP(21); const float* g2 = INP(20); const float* brt = INP(22);
        for (int i = tid; i < 8192; i += NTHREADS) { const f32x4 v = *(const f32x4*)(wr_ + i * 4); *(LAS f32x4*)(WR + i * 4) = v * g2[i >> 3]; }
        if (tid < 32) hist[tid] = 0;
        __syncthreads();
        for (int blk = vcu; blk < 256; blk += G) {
            int e4[4] = {0, 0, 0, 0}, lp4[4] = {0, 0, 0, 0}; float gt4[4] = {0.f, 0.f, 0.f, 0.f}; const int tok0 = blk * 128 + wave * 32; const int hi = lane >> 5, li = lane & 31;
            if (wave < 4) {
                LAS float* scr = (LAS float*)(lds + LDS_X + wave * 4608);
                const float* hrow = H1 + (size_t)(tok0 + li) * 1024 + 4 * hi;
                f32x16 acc; for (int r = 0; r < 16; ++r) acc[r] = 0.f; float ssq = 0.f;
#pragma unroll 4
                for (int s = 0; s < 128; ++s) { const f32x4 v = *(const f32x4*)(hrow + 8 * s); ssq += (v.x * v.x + v.y * v.y) + (v.z * v.z + v.w * v.w);
                    const LAS float* wp = WR + (8 * s + 4 * hi) * 32 + li;
                    acc = __builtin_amdgcn_mfma_f32_32x32x2f32(v.x, wp[0], acc, 0, 0, 0); acc = __builtin_amdgcn_mfma_f32_32x32x2f32(v.y, wp[32], acc, 0, 0, 0);
                    acc = __builtin_amdgcn_mfma_f32_32x32x2f32(v.z, wp[64], acc, 0, 0, 0); acc = __builtin_amdgcn_mfma_f32_32x32x2f32(v.w, wp[96], acc, 0, 0, 0); }
                ssq += __shfl_xor(ssq, 32);
#pragma unroll
                for (int r = 0; r < 16; ++r) scr[((r & 3) + 8 * (r >> 2) + 4 * hi) * 33 + li] = acc[r];
                LDS_WAIT(); asm volatile("" ::: "memory");
                if (lane < 32) { const float rs = 1.0f / sqrtf(ssq * (1.0f / 1024.0f) + NORM_EPS); rs2[tok0 + lane] = rs;
                    float v4[4]; int i0 = -1, i1 = -1, i2 = -1;
#pragma unroll
                    for (int k = 0; k < 4; ++k) { float best = -INFINITY; int bi = 0;
                        for (int e = 0; e < 32; ++e) { const float l = scr[lane * 33 + e] * rs + brt[e]; const bool ok = (e != i0) && (e != i1) && (e != i2); if (ok && l > best) { best = l; bi = e; } }
                        v4[k] = best; e4[k] = bi; if (k == 0) i0 = bi; else if (k == 1) i1 = bi; else if (k == 2) i2 = bi; }
                    const float p1 = __expf(v4[1] - v4[0]), p2 = __expf(v4[2] - v4[0]), p3 = __expf(v4[3] - v4[0]); const float inv = 1.0f / (1.0f + p1 + p2 + p3);
                    gt4[0] = inv; gt4[1] = p1 * inv; gt4[2] = p2 * inv; gt4[3] = p3 * inv;
#pragma unroll
                    for (int k = 0; k < 4; ++k) lp4[k] = __hip_atomic_fetch_add((int*)(hist + e4[k]), 1, __ATOMIC_RELAXED, __HIP_MEMORY_SCOPE_WORKGROUP); }
            }
            __syncthreads();
            if (tid < 32) { const int c = hist[tid]; hbase[tid] = c ? (int)__hip_atomic_fetch_add(ctl + CW_CNT + tid, (unsigned)c, RLX_AGENT) : 0; hist[tid] = 0; }
            __syncthreads();
            if (wave < 4 && lane < 32) { const int t = tok0 + lane;
#pragma unroll
                for (int k = 0; k < 4; ++k) { tope[t * 4 + k] = e4[k]; topg[t * 4 + k] = gt4[k]; spos[t * 4 + k] = hbase[e4[k]] + lp4[k]; } }
            __syncthreads();
        }
        GRID_BAR();
    }
    if (IN(9)) {
        LAS int* tt = (LAS int*)(lds + LDS_X); (void)moe_build_tiles(ctl + CW_CNT, tt, tid); LAS int* st = tt + 1400 + 32;
        for (int s = vcu * NTHREADS + tid; s < T * 4; s += G * NTHREADS) { const int e = tope[s], row = st[e] + spos[s]; srow[s] = row; rtok[row] = s >> 2; rgate[row] = topg[s]; rrs[row] = rs2[s >> 2]; }
        GRID_BAR();
    }
    if (IN(10)) {
        LAS int* tt = (LAS int*)(lds + LDS_X); const int ntiles = moe_build_tiles(ctl + CW_CNT, tt, tid);
        pg8::MoeSched1 S; S.A = (const char*)H1b; S.Bt = (const char*)W1T; S.rtk = rtok; S.tt = tt; S.lda2 = 2048u; S.K2 = 2048u; S.hstepA = 0u; S.nt = 16; S.ntiles = ntiles; S.G = G; S.vc = vcu;
        pg8::EpiMoe1 E{rrs, INP(24), INP(26), Hlo, Hhi}; pg8::gemm_phase(lds, S, E);
        GRID_BAR();
    }
    if (IN(11)) {
        LAS int* tt = (LAS int*)(lds + LDS_X); const int ntiles = moe_build_tiles(ctl + CW_CNT, tt, tid);
        pg8::MoeSched2 S; S.Alo = (const char*)Hlo; S.Ahi = (const char*)Hhi; S.Bt = (const char*)WdT; S.tt = tt; S.lda2 = 2048u; S.K2 = 2048u; S.hstepA = 128u * 2048u; S.nt = 16; S.ntiles = ntiles; S.G = G; S.vc = vcu;
        pg8::EpiMoe2 E{rgate, INP(28), Yb}; pg8::gemm_phase(lds, S, E);
        GRID_BAR();
    }
    if (IN(12)) {
        const float* gf = INP(29);
        const f32x4 gf0 = *(const f32x4*)(gf + lane * 8), gf1 = *(const f32x4*)(gf + lane * 8 + 4), gf2 = *(const f32x4*)(gf + 512 + lane * 8), gf3 = *(const f32x4*)(gf + 512 + lane * 8 + 4);
        for (int t = gw; t < T; t += NGW) {
            f32x4 a0, a1, a2, a3; unpack8(*(const u32x4*)(H1b + (size_t)t * 1024 + lane * 8), a0, a1); unpack8(*(const u32x4*)(H1b + (size_t)t * 1024 + 512 + lane * 8), a2, a3);
#pragma unroll
            for (int k = 0; k < 4; ++k) { const int row = __builtin_amdgcn_readfirstlane(srow[t * 4 + k]); f32x4 y0, y1, y2, y3;
                unpack8(*(const u32x4*)(Yb + (size_t)row * 1024 + lane * 8), y0, y1); unpack8(*(const u32x4*)(Yb + (size_t)row * 1024 + 512 + lane * 8), y2, y3); a0 += y0; a1 += y1; a2 += y2; a3 += y3; }
            float s = 0.f;
#pragma unroll
            for (int j = 0; j < 4; ++j) s += a0[j] * a0[j] + a1[j] * a1[j] + a2[j] * a2[j] + a3[j] * a3[j];
            const float rs = 1.0f / sqrtf(wave_sum(s) * (1.0f / 1024.0f) + NORM_EPS);
            float* o = args.out + (size_t)t * 1024 + lane * 8;
            *(f32x4*)o = a0 * rs * gf0; *(f32x4*)(o + 4) = a1 * rs * gf1; *(f32x4*)(o + 512) = a2 * rs * gf2; *(f32x4*)(o + 516) = a3 * rs * gf3;
        }
    }
#undef IN
#undef GRID_BAR
}

typedef void (*kern_t)(Args);
template <int P> static void get_kerns(kern_t* k) { k[P] = mk_fwd<(1 << P)>; if constexpr (P > 0) get_kerns<P - 1>(k); }
extern "C" void kernel_launch(void* const* d_in, const int* in_sizes, int n_in, void* d_out, int out_size, void* d_ws, size_t ws_size, hipStream_t stream) {
    static int grid = 0; static kern_t kerns[NPHASE + 1];
    if (grid == 0) {
        if (n_in != 30 || in_sizes[0] != T * D || out_size != T * D || ws_size < WS_END) { fprintf(stderr, "kernel_launch: unexpected shapes / workspace (n_in %d, ws %zu)\n", n_in, ws_size); grid = -1; return; }
        int dev = 0, cus = 0, per_cu = 0;
        if (hipGetDevice(&dev) != hipSuccess || hipDeviceGetAttribute(&cus, hipDeviceAttributeMultiprocessorCount, dev) != hipSuccess) { grid = -1; return; }
        if constexpr (MK_N_LAUNCHES == 1) kerns[NPHASE] = mk_fwd<(1 << NPHASE) - 1>; else get_kerns<NPHASE - 1>(kerns);
        for (int p = 0; p <= NPHASE; ++p) if (kerns[p]) {
            if (hipFuncSetAttribute((const void*)kerns[p], hipFuncAttributeMaxDynamicSharedMemorySize, LDS_BYTES) != hipSuccess) { fprintf(stderr, "kernel_launch: hipFuncSetAttribute failed\n"); grid = -1; return; }
            if (hipOccupancyMaxActiveBlocksPerMultiprocessor(&per_cu, (const void*)kerns[p], NTHREADS, LDS_BYTES) != hipSuccess || per_cu < 1) { fprintf(stderr, "kernel_launch: occupancy query reports %d for kernel %d\n", per_cu, p); } }
        (void)hipGetLastError();
        grid = cus;
    }
    if (grid < 0) return;
    (void)hipMemsetAsync((char*)d_ws + WS_CTL, 0, CTL_ZERO_BYTES, stream);
    Args a{};
    for (int i = 0; i < 30; ++i) a.in[i] = (const float*)d_in[i];
    a.out = (float*)d_out; a.ws = (unsigned char*)d_ws;
    if (MK_N_LAUNCHES == 1) { a.ph_lo = 0; a.ph_hi = NPHASE; hipLaunchKernelGGL(kerns[NPHASE], dim3(grid), dim3(NTHREADS), LDS_BYTES, stream, a); }
    else for (int p = 0; p < NPHASE; ++p) { a.ph_lo = p; a.ph_hi = p + 1; hipLaunchKernelGGL(kerns[p], dim3(grid), dim3(NTHREADS), LDS_BYTES, stream, a); }
}
```

```cpp
#include <hip/hip_runtime.h>
#include <cstdio>
#include <cstdint>

#ifndef MK_N_LAUNCHES
#define MK_N_LAUNCHES 1
#endif

#define LAS __attribute__((address_space(3)))
#define GAS __attribute__((address_space(1)))
typedef unsigned short bf16_t;
typedef short bf16x8 __attribute__((ext_vector_type(8)));
typedef float f32x4 __attribute__((ext_vector_type(4)));
typedef float f32x2 __attribute__((ext_vector_type(2)));
typedef float f32x16 __attribute__((ext_vector_type(16)));
typedef unsigned u32x4 __attribute__((ext_vector_type(4)));
typedef unsigned u32x2 __attribute__((ext_vector_type(2)));
typedef short s16x4 __attribute__((ext_vector_type(4)));
typedef int i32x4 __attribute__((ext_vector_type(4)));
typedef int i32x8 __attribute__((ext_vector_type(8)));
typedef GAS unsigned gu32;

constexpr int T = 32768, D = 1024, INW = 3584, NE = 32;
constexpr int AS5_LD = 384;
constexpr float NORM_EPS = 1e-5f;
constexpr int NWAVES = 8, NTHREADS = 512;
constexpr int NPHASE = 13;

constexpr size_t MiB = 1u << 20, KiB = 1024;
constexpr size_t WS_CTL = 0, CTL_ZERO_BYTES = 64 * KiB;
constexpr size_t WS_RS1 = 1 * MiB, WS_RS2 = WS_RS1 + 128 * KiB;
constexpr size_t WS_TOPE = WS_RS2 + 128 * KiB, WS_TOPG = WS_TOPE + 512 * KiB, WS_SPOS = WS_TOPG + 512 * KiB, WS_SROW = WS_SPOS + 512 * KiB;
constexpr int NROWS_CAP = 131072 + 512;
constexpr size_t WS_RTOK = WS_SROW + 512 * KiB, WS_RGATE = WS_RTOK + 640 * KiB, WS_RRS = WS_RGATE + 640 * KiB;
constexpr size_t WS_LAM = WS_RRS + 640 * KiB;
constexpr size_t WS_TRASH = WS_LAM + 64 * KiB;
constexpr size_t WS_BG = WS_TRASH + 128 * KiB, WS_BU = WS_BG + 128 * KiB, WS_BD = WS_BU + 128 * KiB, WS_BGLU = WS_BD + 128 * KiB;
constexpr size_t WS_G2S = WS_BGLU + 4 * KiB;
constexpr size_t WS_WRIMG = WS_G2S + 8 * KiB;
static_assert(WS_WRIMG + 132096 <= 8 * MiB, "tables");
constexpr size_t WS_WDT = 8 * MiB;
constexpr size_t WS_H1F8 = 40 * MiB;
constexpr size_t WS_H1B = 72 * MiB;
constexpr size_t WS_Y = 136 * MiB;
constexpr size_t WS_W1T = 136 * MiB;
constexpr size_t WS_AS5 = 264 * MiB;
constexpr size_t WS_U = 312 * MiB, WS_V = 344 * MiB;
constexpr size_t WS_WINT = 376 * MiB, WS_W1S = 383 * MiB, WS_MT = 387 * MiB;
constexpr size_t WS_HWS = 393 * MiB;
constexpr size_t WS_SST = 393 * MiB, WS_YAB = 425 * MiB, WS_MRG = 200 * MiB, WS_Z = 489 * MiB;
constexpr size_t WS_RT2 = 376 * MiB, WS_RG2 = 380 * MiB, WS_RR2 = 384 * MiB;
constexpr size_t WS_SMALL = 522 * MiB;
constexpr size_t WS_WGLUT = WS_SMALL, WS_WAT = WS_WGLUT + 512 * KiB, WS_WBT = WS_WAT + 1 * MiB, WS_WOT = WS_WBT + 1 * MiB, WS_WM = WS_WOT + 2 * MiB;
constexpr size_t WS_WINT8 = 527 * MiB;
constexpr size_t WS_END = 529 * MiB;
static_assert(WS_WM + 128 * KiB <= WS_END && WS_YAB + 64 * MiB <= WS_SMALL && WS_MRG + 64 * MiB <= WS_V && WS_Y + 257 * MiB <= WS_HWS && WS_MT + 6 * MiB <= WS_HWS, "ws map");
constexpr int HSPLIT = 65536;
constexpr int CW_BAR = 4096, CW_CNT = 8192;

constexpr int LDS_BYTES = 163840;
constexpr int LDS_X = 131072;
constexpr int LDS_AUX = LDS_X + 16384;
constexpr int LDS_MISC = LDS_BYTES - 256;

#define LDS_WAIT() asm volatile("s_waitcnt lgkmcnt(0)" ::: "memory")
#define VM_WAIT() asm volatile("s_waitcnt vmcnt(0)" ::: "memory")
#define RLX_AGENT __ATOMIC_RELAXED, __HIP_MEMORY_SCOPE_AGENT
__device__ __forceinline__ unsigned cvt_pk_bf16(float lo, float hi) { unsigned r; asm volatile("v_cvt_pk_bf16_f32 %0, %1, %2" : "=v"(r) : "v"(lo), "v"(hi)); return r; }
__device__ __forceinline__ float bflo(unsigned w) { return __builtin_bit_cast(float, w << 16); }
__device__ __forceinline__ float bfhi(unsigned w) { return __builtin_bit_cast(float, w & 0xffff0000u); }
__device__ __forceinline__ f32x4 exp2_v(f32x4 x) { return (f32x4){__builtin_amdgcn_exp2f(x[0]), __builtin_amdgcn_exp2f(x[1]), __builtin_amdgcn_exp2f(x[2]), __builtin_amdgcn_exp2f(x[3])}; }
__device__ __forceinline__ f32x4 rcp_v(f32x4 x) { return (f32x4){__builtin_amdgcn_rcpf(x[0]), __builtin_amdgcn_rcpf(x[1]), __builtin_amdgcn_rcpf(x[2]), __builtin_amdgcn_rcpf(x[3])}; }
__device__ __forceinline__ f32x4 sigmoid_v(f32x4 x) { return rcp_v(exp2_v(x * -1.4426950408889634f) + 1.0f); }
__device__ __forceinline__ f32x4 gelu_v(f32x4 x) { const f32x4 u = x * (x * x * (0.044715f * 2.302208198f) + 2.302208198f); return x * rcp_v(exp2_v(-u) + 1.0f); }
__device__ __forceinline__ float wave_sum(float v) {
#pragma unroll
    for (int o = 1; o < 64; o <<= 1) v += __shfl_xor(v, o);
    return v;
}
__device__ __forceinline__ u32x2 pack8_f8(f32x4 a, f32x4 b) {
    int lo = __builtin_amdgcn_cvt_pk_fp8_f32(a[0], a[1], 0, false); lo = __builtin_amdgcn_cvt_pk_fp8_f32(a[2], a[3], lo, true);
    int hi = __builtin_amdgcn_cvt_pk_fp8_f32(b[0], b[1], 0, false); hi = __builtin_amdgcn_cvt_pk_fp8_f32(b[2], b[3], hi, true);
    return (u32x2){(unsigned)lo, (unsigned)hi}; }
__device__ __forceinline__ u32x4 pack8(f32x4 a, f32x4 b) { u32x4 w; w.x = cvt_pk_bf16(a[0], a[1]); w.y = cvt_pk_bf16(a[2], a[3]); w.z = cvt_pk_bf16(b[0], b[1]); w.w = cvt_pk_bf16(b[2], b[3]); return w; }
__device__ __forceinline__ void unpack8(u32x4 w, f32x4& a, f32x4& b) { a = (f32x4){bflo(w.x), bfhi(w.x), bflo(w.y), bfhi(w.y)}; b = (f32x4){bflo(w.z), bfhi(w.z), bflo(w.w), bfhi(w.w)}; }

#define XB_TMO      128
#define XB_XCNT(j)  (256  + 64 * (j))
#define XB_XSUB(j)  (1280 + 64 * (j))
#define XB_XGEN(j)  (2304 + 64 * (j))
#define XB_TOP      3328
#define XB_TOPGEN   3392
#define XCD_BAR_WORDS 3456
#define XB_SPIN_CAP (1u << 20)
__device__ __forceinline__ unsigned xb_ld(unsigned* p)              { return __hip_atomic_load(p, __ATOMIC_RELAXED, __HIP_MEMORY_SCOPE_AGENT); }
__device__ __forceinline__ unsigned xb_add(unsigned* p, unsigned v) { return __hip_atomic_fetch_add(p, v, __ATOMIC_RELAXED, __HIP_MEMORY_SCOPE_AGENT); }
__device__ __forceinline__ unsigned xb_xcc_id() { return (unsigned)__builtin_amdgcn_s_getreg((3 << 11) | 20) & 0xFu; }
#define XB_SPIN(cond, bar) do { unsigned _sp = 0; while (cond) { __builtin_amdgcn_s_sleep(1); \
    if ((++_sp & 255u) == 0u) { if (xb_ld(&(bar)[XB_TMO])) break; if (_sp > XB_SPIN_CAP) { atomicAdd(&(bar)[XB_TMO], 1u); break; } } } } while (0)
struct XcdBarrier { unsigned* bar; unsigned x; volatile LAS unsigned* st; };
__device__ __forceinline__ XcdBarrier xcd_barrier_post(unsigned* bar, volatile LAS unsigned* st) {
    XcdBarrier b; b.bar = bar; b.x = xb_xcc_id(); b.st = st;
    if (threadIdx.x == 0) st[3] = xb_add(&bar[XB_XCNT(b.x)], 1u);
    return b;
}
__device__ __forceinline__ u32x4 pair16_f8(u32x2 a, u32x2 b) {
    const auto s0 = __builtin_amdgcn_permlane16_swap(a.x, b.x, false, false), s1 = __builtin_amdgcn_permlane16_swap(a.y, b.y, false, false);
    return (u32x4){s0[0], s1[0], s0[1], s1[1]};
}
__device__ __forceinline__ void xcd_barrier_complete(unsigned* bar, unsigned x, unsigned& nloc, unsigned& nx, unsigned& uniform) {
    const unsigned G = gridDim.x * gridDim.y * gridDim.z;
    unsigned sum, cnt, mine, sp = 0u;
    for (;;) {
        sum = 0u; cnt = 0u; mine = 0u;
#pragma unroll
        for (unsigned j = 0; j < 16; ++j) { const unsigned c = xb_ld(&bar[XB_XCNT(j)]); sum += c; cnt += (c > 0u) ? 1u : 0u; mine = (j == x) ? c : mine; }
        if (sum == G) break;
        __builtin_amdgcn_s_sleep(1);
        if ((++sp & 255u) == 0u) { if (xb_ld(&bar[XB_TMO])) break; if (sp > XB_SPIN_CAP) { atomicAdd(&bar[XB_TMO], 1u); break; } }
    }
    nloc = mine > 0u ? mine : 1u; nx = cnt > 0u ? cnt : 1u;
    unsigned u = (sum == G && G == 256u) ? 1u : 0u;
#pragma unroll
    for (unsigned j = 0; j < 16; ++j) { const unsigned c = xb_ld(&bar[XB_XCNT(j)]); if (c != (j < 8u ? G / 8u : 0u)) u = 0u; }
    uniform = u;
}
__device__ __forceinline__ void xcd_barrier(const XcdBarrier& b) {
    asm volatile("s_waitcnt vmcnt(0)" ::: "memory");
    __syncthreads();
    if (threadIdx.x == 0) {
        unsigned* bar = b.bar;
        __builtin_amdgcn_s_waitcnt(0);
        unsigned nloc = b.st[0], nx = b.st[1];
        if (nloc == 0u) { unsigned uni = 0u; xcd_barrier_complete(bar, b.x, nloc, nx, uni); b.st[0] = nloc; b.st[1] = nx; b.st[2] = uni; }
        const unsigned old = xb_add(&bar[XB_XSUB(b.x)], 1u);
        const unsigned gen = old / nloc;
        if (old + 1u == (gen + 1u) * nloc) {
            __builtin_amdgcn_fence(__ATOMIC_RELEASE, "agent");
            asm volatile("s_waitcnt vmcnt(0)" ::: "memory");
            const unsigned og = xb_add(&bar[XB_TOP], 1u);
            const unsigned tg = og / nx;
            if (og + 1u == (tg + 1u) * nx) xb_add(&bar[XB_TOPGEN], 1u);
            else XB_SPIN(xb_ld(&bar[XB_TOPGEN]) == tg, bar);
            xb_add(&bar[XB_XGEN(b.x)], 1u);
            __builtin_amdgcn_fence(__ATOMIC_ACQUIRE, "agent");
            asm volatile("s_waitcnt vmcnt(0)" ::: "memory");
        } else {
            XB_SPIN(xb_ld(&bar[XB_XGEN(b.x)]) == gen, bar);
            __builtin_amdgcn_fence(__ATOMIC_ACQUIRE, "agent");
            asm volatile("s_waitcnt vmcnt(0)" ::: "memory");
        }
    }
    __syncthreads();
}

#define XL_CNT(j) (3456 + 64 * (j))
__device__ __forceinline__ void xcd_local_barrier(unsigned* bar, unsigned x, unsigned target) {
    asm volatile("s_waitcnt vmcnt(0)" ::: "memory");
    __syncthreads();
    if (threadIdx.x == 0) {
        __builtin_amdgcn_s_waitcnt(0);
        (void)xb_add(&bar[XL_CNT(x)], 1u);
        XB_SPIN(xb_ld(&bar[XL_CNT(x)]) < target, bar);
        __builtin_amdgcn_fence(__ATOMIC_ACQUIRE, "agent");
        asm volatile("s_waitcnt vmcnt(0)" ::: "memory");
    }
    __syncthreads();
}

namespace pg8 {
constexpr int BM = 256, BK = 64, HALF = 128, HTB = HALF * BK * 2, STAGE_BYTES = 8 * HTB, NXCD = 8, WGM = 8;
__host__ __device__ __forceinline__ int lds_byte(int r, int c) { const int st = (r >> 4) * 2 + (c >> 5), rr = r & 15, cc = c & 31, ob = rr * 64 + cc * 2; return st * 1024 + (ob ^ (((ob >> 9) & 1) << 5)); }
__host__ __device__ __forceinline__ void stage_rc(int b, int& R, int& C) { const int st = b / 1024, sb = b % 1024, swz = sb ^ (((sb >> 9) & 1) << 5); R = (st >> 1) * 16 + swz / 64; C = (st & 1) * 32 + (swz % 64) / 2; }
__host__ __device__ __forceinline__ int perm32(int rho) { const int n = rho >> 4, i = rho & 15; return 8 * (i >> 2) + 4 * n + (i & 3); }

struct Unit { unsigned a, b; int pm, pn, x0, x1; };
__device__ __forceinline__ void tile_order(int L, int nM, int nN, int& pm, int& pn) {
    const int nwg = nM * nN; int wgid = L; { const int q = nwg / NXCD, r = nwg % NXCD, xcd = wgid % NXCD, off = wgid / NXCD; wgid = (xcd < r ? xcd * (q + 1) : r * (q + 1) + (xcd - r) * q) + off; }
    const int nig = WGM * nN, gid = wgid / nig, fm = gid * WGM, gsz = (nM - fm) < WGM ? (nM - fm) : WGM;
    pm = fm + ((wgid % nig) % gsz); pn = (wgid % nig) / gsz;
}

struct NoHook { static constexpr bool ON = false; __device__ __forceinline__ void operator()(int) const {} };
template <class Epi, class Sched, class Hook = NoHook>
__device__ __forceinline__ void gemm_phase(LAS unsigned char* lds, const void* wsbase, const Sched& S, const Epi& E, const Hook& H = Hook{}) {
    const __amdgpu_buffer_rsrc_t rsrc = __builtin_amdgcn_make_buffer_rsrc((void*)wsbase, 0, 0x7fffffff, 0x00020000);
    constexpr bool GATHER = Sched::GATHER, F8 = Sched::F8;
    int tid_ = threadIdx.x; asm volatile("" : "+v"(tid_));
    const int tid = tid_, wid = __builtin_amdgcn_readfirstlane(tid >> 6), lane = tid & 63, wr = wid >> 2, wc = wid & 3, fr = lane & 15, fq = lane >> 4;
    const int nt = S.nt; const unsigned K2 = S.K2, hstepB = 128u * K2, hstepA = S.hstepA;
    unsigned voffA[2], voffB[2];
#pragma unroll
    for (int i = 0; i < 2; ++i) { int R, C; stage_rc(tid * 16 + i * 8192, R, C); const int Rb = (R & ~31) + perm32(R & 31);
        voffA[i] = (unsigned)R * S.lda2 + (unsigned)C * 2u; voffB[i] = (unsigned)Rb * K2 + (unsigned)C * 2u; }
    const unsigned ldsw = (unsigned)wid * 1024u;
    const int aoff = lds_byte(wr * 64 + fr, fq * 8), boff = lds_byte(wc * 32 + fr, fq * 8);
#define PG8_SA(b, h) (((b) * 2 + (h)) * HTB)
#define PG8_SB(b, h) ((4 + (b) * 2 + (h)) * HTB)
#define PG8_GLDS(vo_, so_, lo) __builtin_amdgcn_raw_ptr_buffer_load_lds(rsrc, (LAS void*)(lds + (lo)), 16, (int)(vo_), (int)(so_), 0, 0)
#define PG8_STAGE_B(bufoff, gbase) do { _Pragma("unroll") for (int _i = 0; _i < 2; ++_i) PG8_GLDS(voffB[_i], (gbase), (bufoff) + ldsw + _i * 8192); } while (0)
#define PG8_STAGE_A(bufoff, gbase, h, VO) do { _Pragma("unroll") for (int _i = 0; _i < 2; ++_i) { \
        if constexpr (GATHER) PG8_GLDS(VO[h][_i], (gbase), (bufoff) + ldsw + _i * 8192); \
        else PG8_GLDS(voffA[_i], (gbase) + (h) * hstepA, (bufoff) + ldsw + _i * 8192); } } while (0)
#define PG8_LDA8(dst, b, h) do { _Pragma("unroll") for (int m = 0; m < 4; ++m) { const i32x4 lo_ = *(const LAS i32x4*)(lds + PG8_SA(b, h) + aoff + m * 2048), hi_ = *(const LAS i32x4*)(lds + PG8_SA(b, h) + aoff + m * 2048 + 1024); dst[m] = __builtin_shufflevector(lo_, hi_, 0, 1, 2, 3, 4, 5, 6, 7); } } while (0)
#define PG8_LDB8(dst, b, h) do { _Pragma("unroll") for (int n = 0; n < 2; ++n) { const i32x4 lo_ = *(const LAS i32x4*)(lds + PG8_SB(b, h) + boff + n * 2048), hi_ = *(const LAS i32x4*)(lds + PG8_SB(b, h) + boff + n * 2048 + 1024); dst[n] = __builtin_shufflevector(lo_, hi_, 0, 1, 2, 3, 4, 5, 6, 7); } } while (0)
#define PG8_LDA_(dst, dst8, b, h) do { if constexpr (F8) PG8_LDA8(dst8, b, h); else PG8_LDA(dst, b, h); } while (0)
#define PG8_LDB_(dst, dst8, b, h) do { if constexpr (F8) PG8_LDB8(dst8, b, h); else PG8_LDB(dst, b, h); } while (0)
#define PG8_LDA(dst, b, h) do { _Pragma("unroll") for (int m = 0; m < 4; ++m) _Pragma("unroll") for (int k = 0; k < 2; ++k) dst[m][k] = *(const LAS bf16x8*)(lds + PG8_SA(b, h) + aoff + m * 2048 + k * 1024); } while (0)
#define PG8_LDB(dst, b, h) do { _Pragma("unroll") for (int n = 0; n < 2; ++n) _Pragma("unroll") for (int k = 0; k < 2; ++k) dst[n][k] = *(const LAS bf16x8*)(lds + PG8_SB(b, h) + boff + n * 2048 + k * 1024); } while (0)
#define PG8_MMA(ai, bj, At, Bt) do { __builtin_amdgcn_s_setprio(1); _Pragma("unroll") for (int m = 0; m < 4; ++m) _Pragma("unroll") for (int n = 0; n < 2; ++n) { \
        if constexpr (F8) asm volatile("s_nop 1\n\tv_mfma_scale_f32_16x16x128_f8f6f4 %0, %1, %2, %0, %3, %3 op_sel_hi:[0,0,0]" : "+v"(acc[ai][bj][m][n]) : "v"(Bt##8[n]), "v"(At##8[m]), "v"(f8scale));   \
        else { _Pragma("unroll") for (int k = 0; k < 2; ++k) asm volatile("s_nop 1\n\tv_mfma_f32_16x16x32_bf16 %0, %1, %2, %0" : "+v"(acc[ai][bj][m][n]) : "v"(Bt[n][k]), "v"(At[m][k])); } }   \
        __builtin_amdgcn_s_setprio(0); } while (0)
#define PG8_WAIT_V(n) asm volatile("s_waitcnt vmcnt(" #n ")" ::: "memory")
#define PG8_WAIT_L(n) asm volatile("s_waitcnt lgkmcnt(" #n ")" ::: "memory")
#define PG8_WAIT_VR(tt) asm volatile("s_cmp_eq_u32 %0, 0\n\ts_cbranch_scc0 .Lwv8_%=\n\ts_waitcnt vmcnt(%1)\n\ts_branch .Lwvd_%=\n.Lwv8_%=:\n\ts_waitcnt vmcnt(8)\n.Lwvd_%=:" :: "s"(tt), "i"((8 + Epi::NST) > 63 ? 63 : (8 + Epi::NST)) : "memory", "scc")
#define PG8_BAR __builtin_amdgcn_s_barrier()
#define PG8_SCHED __builtin_amdgcn_sched_barrier(0)
    Unit cur, nxt; int ui = 0;
    if (!S.next(0, cur)) return;
    unsigned cvo[2][2];
    if constexpr (GATHER) S.aoffs(cur, cvo); else { cvo[0][0] = cvo[0][1] = cvo[1][0] = cvo[1][1] = 0u; }
    f32x4 acc[2][2][4][2];
#pragma unroll
    for (int a = 0; a < 2; ++a)
#pragma unroll
        for (int b = 0; b < 2; ++b)
#pragma unroll
            for (int m = 0; m < 4; ++m)
#pragma unroll
                for (int n = 0; n < 2; ++n) acc[a][b][m][n] = (f32x4){0.f, 0.f, 0.f, 0.f};
    const int f8scale = 0x7f7f7f7f;
    bf16x8 At[4][2], B0[2][2], B1[2][2]; i32x8 At8[4], B08[2], B18[2];
    unsigned cA = cur.a, cB = cur.b;
    PG8_STAGE_B(PG8_SB(0, 0), cB); PG8_STAGE_B(PG8_SB(0, 1), cB + hstepB); PG8_STAGE_A(PG8_SA(0, 0), cA, 0, cvo); PG8_STAGE_A(PG8_SA(0, 1), cA, 1, cvo);
    PG8_STAGE_B(PG8_SB(1, 0), cB + 128); PG8_STAGE_B(PG8_SB(1, 1), cB + hstepB + 128);
    if (wr == 1) PG8_BAR;
    PG8_WAIT_V(0); PG8_BAR; PG8_BAR;
    for (;;) {
        const bool has_next = S.next(ui + 1, nxt);
        const unsigned nA = has_next ? nxt.a : cA, nB = has_next ? nxt.b : cB;
        for (int t = 0; t < nt; t += 2) {
            const bool last = (t == nt - 2);
            if constexpr (Epi::MID) { if (t == Epi::TMID) { asm volatile("s_nop 15\n\ts_nop 15" ::: "memory"); E.mid(acc, cur, wr, wc, fr, fq); PG8_SCHED; } }
            const unsigned a1 = cA + (unsigned)(t + 1) * 128u;
            const unsigned a2 = last ? nA : cA + (unsigned)(t + 2) * 128u, b2 = last ? nB : cB + (unsigned)(t + 2) * 128u;
            const unsigned b3 = b2 + 128u;
            PG8_LDB_(B0, B08, 0, 0); PG8_LDB_(B1, B18, 0, 1); PG8_SCHED; PG8_LDA_(At, At8, 0, 0); PG8_STAGE_A(PG8_SA(1, 0), a1, 0, cvo); PG8_STAGE_A(PG8_SA(1, 1), a1, 1, cvo);
            if constexpr (Epi::NAUX > 0) { if (t == 0 && wid < Epi::NAUX) PG8_GLDS(E.auxoff(cur, wid, lane), 0u, LDS_AUX + (ui & 1) * 4096 + wid * 1024); }
            if constexpr (GATHER) { if (t == 0 && wid == 2 && has_next) PG8_GLDS(S.rtkoff(nxt, lane), 0u, LDS_AUX + (ui & 1) * 4096 + 2048); }
            PG8_WAIT_VR(t); PG8_WAIT_L(0); PG8_BAR; PG8_MMA(0, 0, At, B0); PG8_MMA(0, 1, At, B1); PG8_BAR; PG8_SCHED;
            if constexpr (GATHER) { if (last && has_next) S.aoffs_lds(nxt, (const LAS int*)(lds + LDS_AUX + (ui & 1) * 4096 + 2048), cvo); }
            PG8_LDA_(At, At8, 0, 1); PG8_STAGE_B(PG8_SB(0, 0), b2); PG8_STAGE_B(PG8_SB(0, 1), b2 + hstepB);
            PG8_WAIT_V(6); PG8_WAIT_L(0); PG8_BAR; PG8_MMA(1, 0, At, B0); PG8_MMA(1, 1, At, B1); PG8_BAR; PG8_SCHED;
            PG8_LDB_(B0, B08, 1, 0); PG8_LDB_(B1, B18, 1, 1); PG8_SCHED; PG8_LDA_(At, At8, 1, 0); PG8_STAGE_A(PG8_SA(0, 0), a2, 0, cvo); PG8_STAGE_A(PG8_SA(0, 1), a2, 1, cvo);
            PG8_WAIT_V(8); PG8_WAIT_L(0); PG8_BAR; PG8_MMA(0, 0, At, B0); PG8_MMA(0, 1, At, B1); PG8_BAR; PG8_SCHED;
            PG8_LDA_(At, At8, 1, 1); PG8_STAGE_B(PG8_SB(1, 0), b3); PG8_STAGE_B(PG8_SB(1, 1), b3 + hstepB);
            PG8_WAIT_V(6); PG8_WAIT_L(0); PG8_BAR; PG8_MMA(1, 0, At, B0); PG8_MMA(1, 1, At, B1); PG8_BAR; PG8_SCHED;
        }
        if (wr == 0) PG8_BAR;
        asm volatile("s_nop 15\n\ts_nop 15" ::: "memory");
        E(acc, cur, wr, wc, fr, fq, lds + LDS_AUX + (ui & 1) * 4096);
        PG8_SCHED;
        if constexpr (Hook::ON) { H(ui); PG8_SCHED; }
        if (!has_next) break;
#pragma unroll
        for (int a = 0; a < 2; ++a)
#pragma unroll
            for (int b = 0; b < 2; ++b)
#pragma unroll
                for (int m = 0; m < 4; ++m)
#pragma unroll
                    for (int n = 0; n < 2; ++n) acc[a][b][m][n] = (f32x4){0.f, 0.f, 0.f, 0.f};
        cur = nxt; cA = nA; cB = nB; ++ui;
        if (wr == 1) PG8_BAR;
    }
    PG8_WAIT_V(0);
    PG8_BAR;
#undef PG8_SA
#undef PG8_SB
#undef PG8_GLDS
#undef PG8_STAGE_A
#undef PG8_STAGE_B
#undef PG8_LDA
#undef PG8_LDB
#undef PG8_MMA
#undef PG8_LDA8
#undef PG8_LDB8
#undef PG8_LDA_
#undef PG8_LDB_
#undef PG8_WAIT_V
#undef PG8_WAIT_L
#undef PG8_WAIT_VR
#undef PG8_BAR
#undef PG8_SCHED
}

template <bool F8_>
struct DenseSchedT {
    static constexpr bool GATHER = false, F8 = F8_;
    unsigned A, Bt; unsigned lda2, K2, hstepA; int nt, nM, nN, nwg, G, c;
    __device__ __forceinline__ void init(size_t A_, size_t Bt_, int M, int N, int K, int lda, int G_, int c_) {
        constexpr unsigned esz = F8_ ? 1u : 2u;
        A = (unsigned)A_; Bt = (unsigned)Bt_; lda2 = (unsigned)lda * esz; K2 = (unsigned)K * esz; hstepA = 128u * lda2; nt = (int)(K2 / 128u); nM = M / 256; nN = N / 256; nwg = nM * nN; G = G_; c = c_; }
    __device__ __forceinline__ bool next(int i, Unit& u) const {
        const long L = (long)i * G + c; if (L >= nwg) return false;
        tile_order((int)L, nM, nN, u.pm, u.pn);
        u.a = A + (unsigned)u.pm * 256u * lda2; u.b = Bt + (unsigned)u.pn * 256u * K2; u.x0 = 0; u.x1 = 0; return true; }
    __device__ __forceinline__ void aoffs(const Unit&, unsigned (&)[2][2]) const {}
};
typedef DenseSchedT<false> DenseSched;
struct S5Sched {
    static constexpr bool GATHER = false, F8 = false;
    unsigned A, Bt; unsigned lda2, K2, hstepA; int nt, id;
    __device__ __forceinline__ void init(size_t A_, size_t Bt_, int K, int id_) { A = (unsigned)A_; Bt = (unsigned)Bt_; lda2 = AS5_LD * 2; K2 = (unsigned)K * 2u; hstepA = 128u * lda2; nt = K / 64; id = id_; }
    __device__ __forceinline__ bool next(int i, Unit& u) const {
        if (i > 0 || id >= 256) return false;
        const int g = id >> 3; u.pm = id & 7; u.pn = 0; u.x0 = g; u.x1 = 0;
        u.a = A + ((unsigned)g * 2048u + (unsigned)u.pm * 256u) * lda2; u.b = Bt + (unsigned)g * 256u * K2; return true; }
    __device__ __forceinline__ void aoffs(const Unit&, unsigned (&)[2][2]) const {}
};
struct MoeSched1 {
    static constexpr bool GATHER = true, F8 = true;
    unsigned A, Bt; const int* rtk; const LAS int* tt; unsigned lda2, K2, hstepA; int nt, ntiles, G, vc;
    __device__ __forceinline__ bool next(int i, Unit& u) const {
        const int L = i * G + vc; const int tile = L >> 3; if (tile >= ntiles) return false;
        const int w0 = __builtin_amdgcn_readfirstlane(tt[2 * tile]), row0 = __builtin_amdgcn_readfirstlane(tt[2 * tile + 1]);
        const int e = w0 & 255; u.pm = e * T + (row0 - __builtin_amdgcn_readfirstlane(tt[1432 + e])); u.pn = L & 7; u.x0 = row0; u.x1 = w0;
        u.a = A; u.b = Bt + ((unsigned)e * 2048u + (unsigned)u.pn * 256u) * K2; return true; }
    __device__ __forceinline__ unsigned rtkoff(const Unit& u, int lane) const { return (unsigned)WS_RT2 + (unsigned)u.pm * 4u + (unsigned)lane * 16u; }
    __device__ __forceinline__ void aoffs_lds(const Unit& u, const LAS int* tl, unsigned (&vo)[2][2]) const {
        const int nrows = u.x1 >> 8; int Rr[2], Cc[2];
        { int t_ = threadIdx.x; asm volatile("" : "+v"(t_));
#pragma unroll
        for (int i = 0; i < 2; ++i) stage_rc(t_ * 16 + i * 8192, Rr[i], Cc[i]); }
#pragma unroll
        for (int h = 0; h < 2; ++h)
#pragma unroll
            for (int i = 0; i < 2; ++i) { const int rl = h * 128 + Rr[i]; const int tok = rl < nrows ? tl[rl] : 0; vo[h][i] = (unsigned)tok * 1024u + (unsigned)Cc[i] * 2u; }
    }
    __device__ __forceinline__ void aoffs(const Unit& u, unsigned (&vo)[2][2]) const {
        const int nrows = u.x1 >> 8; int Rr[2], Cc[2];
        { int t_ = threadIdx.x; asm volatile("" : "+v"(t_));
#pragma unroll
        for (int i = 0; i < 2; ++i) stage_rc(t_ * 16 + i * 8192, Rr[i], Cc[i]); }
#pragma unroll
        for (int h = 0; h < 2; ++h)
#pragma unroll
            for (int i = 0; i < 2; ++i) { const int rl = h * 128 + Rr[i]; const int tok = rl < nrows ? rtk[u.pm + rl] : 0; vo[h][i] = (unsigned)tok * 1024u + (unsigned)Cc[i] * 2u; }
    }
};
struct MoeSched2 {
    static constexpr bool GATHER = false, F8 = true;
    unsigned Ahi, Bt; const LAS int* tt; unsigned lda2, K2, hstepA; int nt, ntiles, G, vc;
    __device__ __forceinline__ bool next(int i, Unit& u) const {
        const int L = i * G + vc; const int tile = L >> 2; if (tile >= ntiles) return false;
        const int w0 = __builtin_amdgcn_readfirstlane(tt[2 * tile]), row0 = __builtin_amdgcn_readfirstlane(tt[2 * tile + 1]);
        const int e = w0 & 255; u.pm = e * T + (row0 - __builtin_amdgcn_readfirstlane(tt[1432 + e])); u.pn = L & 3; u.x0 = row0; u.x1 = w0;
        u.a = Ahi + (unsigned)row0 * 1024u; u.b = Bt + ((unsigned)e * 1024u + (unsigned)u.pn * 256u) * K2; return true; }
    __device__ __forceinline__ void aoffs(const Unit&, unsigned (&)[2][2]) const {}
};

#define EPI_ARGS const f32x4 (&acc)[2][2][4][2], const Unit& u, int wr, int wc, int fr_in, int fq_in, const LAS unsigned char* aux
#define EPI_LAUNDER int fr = fr_in, fq = fq_in; asm volatile("" : "+v"(fr), "+v"(fq));
#define INP_F8_GROUPS {0, 2}
#define INP_BF_GROUPS {1}
#define MOE_KSG 2.455467f
#define INP_NF8 2
#define INP_NBF 1
struct EpiInProj {
    static constexpr bool MID = false; static constexpr int TMID = 0; static constexpr int NAUX = 1;
    static constexpr int NST = 16;
    __device__ __forceinline__ unsigned auxoff(const Unit& u, int, int lane) const { return (unsigned)WS_RS1 + (unsigned)(u.pm * 256) * 4u + (unsigned)lane * 16u; }
    bf16_t *AS5, *U, *V; int pmap; float wsc;
    __device__ __forceinline__ void operator()(EPI_ARGS) const {
        EPI_LAUNDER
        const int row0 = u.pm * 256 + wr * 64 + fr, colw = wc * 32 + 8 * fq, pn = (pmap >> (4 * u.pn)) & 15;
        const int mode = pn < 2 ? 0 : 1;
#pragma unroll
        for (int ai = 0; ai < 2; ++ai)
#pragma unroll
            for (int m = 0; m < 4; ++m) { const int row = row0 + ai * 128 + m * 16; const float rs = ((const LAS float*)aux)[ai * 128 + wr * 64 + m * 16 + fr] * wsc;
#pragma unroll
                for (int bj = 0; bj < 2; ++bj) { const int c = pn * 256 + bj * 128 + colw; f32x4 v0 = acc[ai][bj][m][0] * rs, v1 = acc[ai][bj][m][1] * rs; bf16_t* dst;
                    if (mode == 0) { dst = AS5 + ((size_t)((c >> 4) * 2048 + (row >> 4)) * AS5_LD + (row & 15) * 16 + (c & 15)); }
                    else {
                        v0 = gelu_v(v0); v1 = gelu_v(v1);
                        dst = (pn < 4 ? U + (size_t)row * 512 + (c - 512) : V + (size_t)row * 512 + (c - 1024)); }
                    *(u32x4*)dst = pack8(v0, v1); } }
    }
};
struct EpiGates {
    static constexpr bool MID = false; static constexpr int TMID = 0; static constexpr int NAUX = 1;
    static constexpr int NST = 16;
    __device__ __forceinline__ unsigned auxoff(const Unit& u, int, int lane) const { return (unsigned)WS_RS1 + (unsigned)(u.pm * 256) * 4u + (unsigned)lane * 16u; }
    bf16_t *GA, *GB;
    __device__ __forceinline__ void operator()(EPI_ARGS) const {
        EPI_LAUNDER
        const int row0 = u.pm * 256 + wr * 64 + fr, c = u.pn * 128 + wc * 32 + 8 * fq;
#pragma unroll
        for (int ai = 0; ai < 2; ++ai)
#pragma unroll
            for (int m = 0; m < 4; ++m) { const int row = row0 + ai * 128 + m * 16; const float rs = ((const LAS float*)aux)[ai * 128 + wr * 64 + m * 16 + fr] * 0.03125f;
                f32x4 a0 = acc[ai][0][m][0] * rs, a1 = acc[ai][0][m][1] * rs, b0 = acc[ai][1][m][0] * rs, b1 = acc[ai][1][m][1] * rs;
                { const f32x4 ea = exp2_v(a0 * -1.4426950408889634f) + 1.0f, eb = exp2_v(b0 * -1.4426950408889634f) + 1.0f, ec = exp2_v(a1 * -1.4426950408889634f) + 1.0f, ed = exp2_v(b1 * -1.4426950408889634f) + 1.0f;
                  b0 = rcp_v(eb); a0 = eb * rcp_v(ea); b1 = rcp_v(ed); a1 = ed * rcp_v(ec); }
                const size_t off = (size_t)row * 1024 + c; *(u32x4*)(GA + off) = pack8(a0, a1); *(u32x4*)(GB + off) = pack8(b0, b1); }
    }
};
struct EpiS5End {
    static constexpr bool MID = false; static constexpr int TMID = 0; static constexpr int NAUX = 0;
    static constexpr int NST = 16;
    float* SST;
    __device__ __forceinline__ void operator()(EPI_ARGS) const {
        EPI_LAUNDER
        const int row0 = u.pm * 256 + wr * 64 + fr, colw = wc * 32 + 8 * fq, g = u.x0;
#pragma unroll
        for (int ai = 0; ai < 2; ++ai)
#pragma unroll
            for (int m = 0; m < 4; ++m) { const int row = row0 + ai * 128 + m * 16; float* dst = SST + (size_t)row * 4096 + g * 128 + colw;
                *(f32x4*)dst = acc[ai][0][m][0]; *(f32x4*)(dst + 4) = acc[ai][0][m][1]; }
    }
};
struct EpiS5Out {
    static constexpr bool MID = false; static constexpr int TMID = 0; static constexpr int NAUX = 0;
    static constexpr int NST = 16;
    bf16_t* Z;
    __device__ __forceinline__ void operator()(EPI_ARGS) const {
        EPI_LAUNDER
        const int row0 = u.pm * 256 + wr * 64 + fr, colw = wc * 32 + 8 * fq, g = u.x0;
#pragma unroll
        for (int ai = 0; ai < 2; ++ai)
#pragma unroll
            for (int m = 0; m < 4; ++m) { const int row = row0 + ai * 128 + m * 16;
#pragma unroll
                for (int bj = 0; bj < 2; ++bj) { const int c = bj * 128 + colw; f32x4 v0 = acc[ai][bj][m][0], v1 = acc[ai][bj][m][1];
                    v0 = gelu_v(v0); v1 = gelu_v(v1);
                    *(u32x4*)(Z + ((size_t)row * 16 + (c >> 4)) * 512 + g * 16 + (c & 15)) = pack8(v0, v1); } }
    }
};
struct EpiGlu {
    static constexpr bool MID = false; static constexpr int TMID = 0; static constexpr int NAUX = 1;
    static constexpr int NST = 16;
    __device__ __forceinline__ unsigned auxoff(const Unit& u, int, int lane) const { return (unsigned)WS_BGLU + (unsigned)(u.pn * 256) * 4u + (unsigned)lane * 16u; }
    const bf16_t* Z; const float* bglu; bf16_t* YA;
    __device__ __forceinline__ void operator()(EPI_ARGS) const {
        EPI_LAUNDER
        const int row0 = u.pm * 256 + wr * 64 + fr, colw = wc * 32 + 8 * fq;
        f32x4 bb[2][2];
#pragma unroll
        for (int bj = 0; bj < 2; ++bj) { bb[bj][0] = *(const LAS f32x4*)(aux + (bj * 128 + colw) * 4); bb[bj][1] = *(const LAS f32x4*)(aux + (bj * 128 + colw) * 4 + 16); }
#pragma unroll
        for (int ai = 0; ai < 2; ++ai) { u32x4 rr[4][2];
#pragma unroll
            for (int m = 0; m < 4; ++m)
#pragma unroll
                for (int bj = 0; bj < 2; ++bj) rr[m][bj] = *(const u32x4*)(Z + (size_t)(row0 + ai * 128 + m * 16) * 512 + u.pn * 256 + bj * 128 + colw);
#pragma unroll
            for (int m = 0; m < 4; ++m)
#pragma unroll
                for (int bj = 0; bj < 2; ++bj) { const int row = row0 + ai * 128 + m * 16, c = u.pn * 256 + bj * 128 + colw;
                    f32x4 z0, z1; unpack8(rr[m][bj], z0, z1); f32x4 v0 = acc[ai][bj][m][0] + bb[bj][0], v1 = acc[ai][bj][m][1] + bb[bj][1];
                    v0 = z0 * sigmoid_v(v0); v1 = z1 * sigmoid_v(v1);
                    *(u32x4*)(YA + (size_t)row * 1024 + c) = pack8(v0, v1); }
            asm volatile("" ::: "memory"); }
    }
};
struct EpiMerge {
    static constexpr bool MID = true; static constexpr int TMID = 8; static constexpr int NAUX = 0;
    static constexpr int NST = 16;
    const bf16_t *GA, *GB; bf16_t* MRG;
    __device__ __forceinline__ void mid(f32x4 (&acc)[2][2][4][2], const Unit& u, int wr, int wc, int fr_in, int fq_in) const {
        EPI_LAUNDER
        const int row0 = u.pm * 256 + wr * 64 + fr, colw = wc * 32 + 8 * fq;
#pragma unroll
        for (int ai = 0; ai < 2; ++ai) { u32x4 rr[4][2];
#pragma unroll
            for (int m = 0; m < 4; ++m)
#pragma unroll
                for (int bj = 0; bj < 2; ++bj) rr[m][bj] = *(const u32x4*)(GA + (size_t)(row0 + ai * 128 + m * 16) * 1024 + u.pn * 256 + bj * 128 + colw);
#pragma unroll
            for (int m = 0; m < 4; ++m)
#pragma unroll
                for (int bj = 0; bj < 2; ++bj) { f32x4 a0, a1; unpack8(rr[m][bj], a0, a1); acc[ai][bj][m][0] *= a0; acc[ai][bj][m][1] *= a1; }
            asm volatile("" ::: "memory"); }
    }
    __device__ __forceinline__ void operator()(EPI_ARGS) const {
        EPI_LAUNDER
        const int row0 = u.pm * 256 + wr * 64 + fr, colw = wc * 32 + 8 * fq;
#pragma unroll
        for (int ai = 0; ai < 2; ++ai) { u32x4 rr[4][2];
#pragma unroll
            for (int m = 0; m < 4; ++m)
#pragma unroll
                for (int bj = 0; bj < 2; ++bj) rr[m][bj] = *(const u32x4*)(GB + (size_t)(row0 + ai * 128 + m * 16) * 1024 + u.pn * 256 + bj * 128 + colw);
#pragma unroll
            for (int m = 0; m < 4; ++m)
#pragma unroll
                for (int bj = 0; bj < 2; ++bj) { const size_t off = (size_t)(row0 + ai * 128 + m * 16) * 1024 + u.pn * 256 + bj * 128 + colw;
                    f32x4 b0, b1; unpack8(rr[m][bj], b0, b1); *(u32x4*)(MRG + off) = pack8(acc[ai][bj][m][0] * b0, acc[ai][bj][m][1] * b1); }
            asm volatile("" ::: "memory"); }
    }
};
struct EpiOutProj {
    static constexpr bool MID = false; static constexpr int TMID = 0; static constexpr int NAUX = 0;
    static constexpr int NST = 24;
    bf16_t* H1b; unsigned char* H1f8;
    __device__ __forceinline__ void operator()(EPI_ARGS) const {
        EPI_LAUNDER
        const int row0 = u.pm * 256 + wr * 64 + fr, colw = wc * 32 + 8 * fq;
#pragma unroll
        for (int ai = 0; ai < 2; ++ai) { u32x4 rr[4][2];
#pragma unroll
            for (int m = 0; m < 4; ++m)
#pragma unroll
                for (int bj = 0; bj < 2; ++bj) rr[m][bj] = *(const u32x4*)(H1b + (size_t)(row0 + ai * 128 + m * 16) * 1024 + u.pn * 256 + bj * 128 + colw);
#pragma unroll
            for (int mp = 0; mp < 2; ++mp)
#pragma unroll
                for (int bj = 0; bj < 2; ++bj) { u32x2 h8[2];
#pragma unroll
                    for (int q = 0; q < 2; ++q) { const int m = 2 * mp + q; const size_t off = (size_t)(row0 + ai * 128 + m * 16) * 1024 + u.pn * 256 + bj * 128 + colw;
                        f32x4 x0, x1; unpack8(rr[m][bj], x0, x1); const f32x4 v0 = acc[ai][bj][m][0] + x0, v1 = acc[ai][bj][m][1] + x1;
                        *(u32x4*)(H1b + off) = pack8(v0, v1); h8[q] = pack8_f8(v0, v1); }
                    *(u32x4*)(H1f8 + (size_t)(row0 + ai * 128 + mp * 32 + 16 * (fq & 1)) * 1024 + u.pn * 256 + bj * 128 + wc * 32 + 16 * (fq >> 1)) = pair16_f8(h8[0], h8[1]); }
            asm volatile("" ::: "memory"); }
    }
};
struct EpiMoe1 {
    static constexpr bool MID = false; static constexpr int TMID = 0; static constexpr int NAUX = 2;
    static constexpr int NST = 4;
    __device__ __forceinline__ unsigned auxoff(const Unit& u, int piece, int lane) const { const int e = u.x1 & 255;
        return piece == 0 ? (unsigned)WS_RR2 + (unsigned)u.pm * 4u + (unsigned)lane * 16u : (lane < 32 ? (unsigned)WS_BG : (unsigned)WS_BU - 512u) + (unsigned)(e * 1024 + u.pn * 128) * 4u + (unsigned)lane * 16u; }
    const float *rrs, *bgate, *bup; unsigned char *H8, *trash;
    __device__ __forceinline__ void operator()(EPI_ARGS) const {
        EPI_LAUNDER
        const int rl0 = wr * 64 + fr, colw = wc * 32 + 8 * fq, row0 = u.x0, nrows = u.x1 >> 8, e = u.x1 & 255; const int c = u.pn * 128 + wc * 32 + 16 * (fq >> 1);
        const LAS float* ab = (const LAS float*)(aux + 1024); const f32x4 bg0 = *(const LAS f32x4*)(ab + colw), bg1 = *(const LAS f32x4*)(ab + colw + 4), bu0 = *(const LAS f32x4*)(ab + 128 + colw), bu1 = *(const LAS f32x4*)(ab + 128 + colw + 4);
        unsigned char* Hb = H8 + (size_t)row0 * 1024;
#pragma unroll
        for (int ai = 0; ai < 2; ++ai)
#pragma unroll
            for (int mp = 0; mp < 2; ++mp) { u32x2 hp[2];
#pragma unroll
                for (int q = 0; q < 2; ++q) { const int m = 2 * mp + q; const float rs = ((const LAS float*)aux)[rl0 + ai * 128 + m * 16] * 0.03125f;
                    f32x4 g0 = acc[ai][0][m][0] * rs + bg0, g1 = acc[ai][0][m][1] * rs + bg1, l0 = acc[ai][1][m][0] * rs + bu0, l1 = acc[ai][1][m][1] * rs + bu1;
                    { const f32x4 gmax = (f32x4){7.0f * MOE_KSG, 7.0f * MOE_KSG, 7.0f * MOE_KSG, 7.0f * MOE_KSG}, lmin = (f32x4){-6.0f / MOE_KSG, -6.0f / MOE_KSG, -6.0f / MOE_KSG, -6.0f / MOE_KSG}, lmax = (f32x4){8.0f / MOE_KSG, 8.0f / MOE_KSG, 8.0f / MOE_KSG, 8.0f / MOE_KSG};
                      g0 = __builtin_elementwise_min(g0, gmax); g1 = __builtin_elementwise_min(g1, gmax);
                      l0 = __builtin_elementwise_min(__builtin_elementwise_max(l0, lmin), lmax); l1 = __builtin_elementwise_min(__builtin_elementwise_max(l1, lmin), lmax);
                      g0 = g0 * rcp_v(exp2_v(-g0) + 1.0f) * l0; g1 = g1 * rcp_v(exp2_v(-g1) + 1.0f) * l1; }
                    hp[q] = pack8_f8(g0, g1); }
                const int rl = rl0 + ai * 128 + mp * 32 + 16 * (fq & 1); const bool ok = rl < nrows;
                unsigned char* dst = ok ? Hb + (size_t)rl * 1024 + c : trash + (size_t)(rl & 63) * 1024 + c;
                *(u32x4*)dst = pair16_f8(hp[0], hp[1]); }
    }
};
struct EpiMoe2 {
    static constexpr bool MID = false; static constexpr int TMID = 0; static constexpr int NAUX = 2;
    static constexpr int NST = 8;
    __device__ __forceinline__ unsigned auxoff(const Unit& u, int piece, int lane) const { const int e = u.x1 & 255;
        return piece == 0 ? (unsigned)WS_RG2 + (unsigned)u.pm * 4u + (unsigned)lane * 16u : (unsigned)WS_BD + (unsigned)(e * 1024 + u.pn * 256) * 4u + (unsigned)lane * 16u; }
    const float *rgate, *bdown; unsigned char *Y, *trash;
    __device__ __forceinline__ void operator()(EPI_ARGS) const {
        EPI_LAUNDER
        const int rl0 = wr * 64 + fr, colw = wc * 32 + 8 * fq, row0 = u.x0, nrows = u.x1 >> 8, e = u.x1 & 255;
#pragma unroll
        for (int bj = 0; bj < 2; ++bj) { const int c = u.pn * 256 + bj * 128 + wc * 32 + 16 * (fq >> 1); const f32x4 b0 = *(const LAS f32x4*)(aux + 1024 + (bj * 128 + colw) * 4) * 32.0f, b1 = *(const LAS f32x4*)(aux + 1024 + (bj * 128 + colw) * 4 + 16) * 32.0f;
#pragma unroll
            for (int ai = 0; ai < 2; ++ai)
#pragma unroll
                for (int mp = 0; mp < 2; ++mp) { const int rla = rl0 + ai * 128 + mp * 32; const float ga = ((const LAS float*)aux)[rla] * 0.5f, gb = ((const LAS float*)aux)[rla + 16] * 0.5f;
                    const u32x4 o = pair16_f8(pack8_f8((acc[ai][bj][2 * mp][0] + b0) * ga, (acc[ai][bj][2 * mp][1] + b1) * ga), pack8_f8((acc[ai][bj][2 * mp + 1][0] + b0) * gb, (acc[ai][bj][2 * mp + 1][1] + b1) * gb));
                    const int rl = rla + 16 * (fq & 1); const bool ok = rl < nrows;
                    unsigned char* dst = ok ? Y + (size_t)(row0 + rl) * 1024 + c : trash + (size_t)(rl & 63) * 1024 + c;
                    *(u32x4*)dst = o; } }
    }
};
}

struct TrJob { const float* W; const float* ks; bf16_t* WT; int ldw, ldt, k0, n0, add, f8; };
__device__ __forceinline__ void transpose_load(const TrJob& j, int lane, f32x4 (&v)[8]) {
    const int kg = lane >> 3, ng = lane & 7; const float* p = j.W + (size_t)(j.k0 + 8 * kg) * j.ldw + j.n0 + 4 * ng;
#pragma unroll
    for (int e = 0; e < 8; ++e) v[e] = __builtin_nontemporal_load((const f32x4*)(p + (size_t)e * j.ldw));
}
__device__ __forceinline__ void transpose_store(const TrJob& j, int lane, f32x4 (&v)[8]) {
    const int kg = lane >> 3, ng = lane & 7;
    if (j.ks) { const f32x4 s0 = *(const f32x4*)(j.ks + j.k0 + 8 * kg), s1 = *(const f32x4*)(j.ks + j.k0 + 8 * kg + 4);
#pragma unroll
        for (int e = 0; e < 4; ++e) { v[e] *= s0[e]; v[4 + e] *= s1[e]; } }
#pragma unroll
    for (int c = 0; c < 4; ++c) { const int n = j.n0 + 4 * ng + c; const int row = j.add < 0 ? n : ((n >> 7) * 256 + (n & 127) + j.add);
        if (j.f8) { *(u32x2*)((unsigned char*)j.WT + (size_t)row * j.ldt + j.k0 + 8 * kg) = pack8_f8((f32x4){v[0][c], v[1][c], v[2][c], v[3][c]} * 32.0f, (f32x4){v[4][c], v[5][c], v[6][c], v[7][c]} * 32.0f); }
        else { u32x4 o; o.x = cvt_pk_bf16(v[0][c], v[1][c]); o.y = cvt_pk_bf16(v[2][c], v[3][c]); o.z = cvt_pk_bf16(v[4][c], v[5][c]); o.w = cvt_pk_bf16(v[6][c], v[7][c]);
            *(u32x4*)(j.WT + (size_t)row * j.ldt + j.k0 + 8 * kg) = o; } }
}

__device__ __forceinline__ void transpose8_load(const TrJob& j, int lane, f32x4 (&v)[16]) {
    const int kg = lane >> 3, ng = lane & 7; const float* p = j.W + (size_t)(j.k0 + 16 * kg) * j.ldw + j.n0 + 4 * ng;
#pragma unroll
    for (int e = 0; e < 16; ++e) v[e] = __builtin_nontemporal_load((const f32x4*)(p + (size_t)e * j.ldw));
}
__device__ __forceinline__ void transpose8_store(const TrJob& j, int lane, f32x4 (&v)[16]) {
    const int kg = lane >> 3, ng = lane & 7;
    if (j.ks) {
#pragma unroll
        for (int q = 0; q < 4; ++q) { const f32x4 s = *(const f32x4*)(j.ks + j.k0 + 16 * kg + 4 * q);
#pragma unroll
            for (int e = 0; e < 4; ++e) v[4 * q + e] *= s[e]; } }
#pragma unroll
    for (int c = 0; c < 4; ++c) { const int n = j.n0 + 4 * ng + c; const int row = j.add < 0 ? n : ((n >> 7) * 256 + (n & 127) + j.add);
        const u32x2 lo = pack8_f8((f32x4){v[0][c], v[1][c], v[2][c], v[3][c]} * 32.0f, (f32x4){v[4][c], v[5][c], v[6][c], v[7][c]} * 32.0f);
        const u32x2 hi = pack8_f8((f32x4){v[8][c], v[9][c], v[10][c], v[11][c]} * 32.0f, (f32x4){v[12][c], v[13][c], v[14][c], v[15][c]} * 32.0f);
        *(u32x4*)((unsigned char*)j.WT + (size_t)row * j.ldt + j.k0 + 16 * kg) = (u32x4){lo.x, lo.y, hi.x, hi.y}; }
}

__device__ __forceinline__ void transpose8_store_sc(const TrJob& j, int lane, f32x4 (&v)[16], const f32x4 (&sc)[4]) {
    const int kg = lane >> 3, ng = lane & 7;
#pragma unroll
    for (int c = 0; c < 4; ++c) { const int n = j.n0 + 4 * ng + c; const int row = j.add < 0 ? n : ((n >> 7) * 256 + (n & 127) + j.add);
        const u32x2 lo = pack8_f8((f32x4){v[0][c], v[1][c], v[2][c], v[3][c]} * sc[0], (f32x4){v[4][c], v[5][c], v[6][c], v[7][c]} * sc[1]);
        const u32x2 hi = pack8_f8((f32x4){v[8][c], v[9][c], v[10][c], v[11][c]} * sc[2], (f32x4){v[12][c], v[13][c], v[14][c], v[15][c]} * sc[3]);
        *(u32x4*)((unsigned char*)j.WT + (size_t)row * j.ldt + j.k0 + 16 * kg) = (u32x4){lo.x, lo.y, hi.x, hi.y}; }
}

struct Args { const float* in[30]; float* out; unsigned char* ws; int ph_lo, ph_hi; };
__device__ __forceinline__ const float* in_ptr_(int byte_off) { const float* p; asm volatile("s_load_dwordx2 %0, %1, %2\n\ts_waitcnt lgkmcnt(0)" : "=s"(p) : "s"(__builtin_amdgcn_kernarg_segment_ptr()), "i"(byte_off)); return p; }
#define INP(k) in_ptr_((k) * 8)


__device__ __forceinline__ void s5_build_group(const Args& args, int g, LAS unsigned char* lds, int tid) {
    const float *lam_re = INP(3), *lam_im = INP(4), *log_dt = INP(5), *b_re = INP(6), *b_im = INP(7), *c_re = INP(8), *c_im = INP(9), *d_skip = INP(10);
    LAS f32x2* pw = (LAS f32x2*)lds;
    LAS f32x2* bb = pw + 17 * 64;
    LAS f32x2* Cg = bb + 64 * 16;
    LAS float* Kt = (LAS float*)(Cg + 16 * 64);
    bf16_t* W1s = (bf16_t*)(args.ws + WS_W1S) + (size_t)g * 256 * 256;
    bf16_t* MT = (bf16_t*)(args.ws + WS_MT) + (size_t)g * 256 * 384;
    f32x2* lamtab = (f32x2*)(args.ws + WS_LAM);
    { const float dt = expf(log_dt[g]);
      for (int i = tid; i < 19 * 64; i += NTHREADS) { const int m = i >> 6, n = i & 63; const float lr = lam_re[g * 64 + n], li = lam_im[g * 64 + n];
          const float mf = m <= 16 ? (float)m : (m == 17 ? 16.0f : 512.0f); const float mag = expf(lr * dt * mf); float sn, cs; sincosf(li * dt * mf, &sn, &cs);
          if (m <= 16) pw[m * 64 + n] = (f32x2){mag * cs, mag * sn}; else lamtab[(m - 17) * 2048 + g * 64 + n] = (f32x2){mag * cs, mag * sn}; } }
    __syncthreads();
    for (int i = tid; i < 1024; i += NTHREADS) { const int n = i >> 4, q = i & 15; const float lr = lam_re[g * 64 + n], li = lam_im[g * 64 + n];
        const f32x2 lb = pw[64 + n]; const float nr = lb.x - 1.0f, ni = lb.y, den = 1.0f / (lr * lr + li * li);
        const float cr = (nr * lr + ni * li) * den, ci = (ni * lr - nr * li) * den;
        const float br = b_re[(g * 64 + n) * 16 + q], bi = b_im[(g * 64 + n) * 16 + q]; bb[n * 16 + q] = (f32x2){cr * br - ci * bi, cr * bi + ci * br}; }
    for (int i = tid; i < 1024; i += NTHREADS) Cg[i] = (f32x2){c_re[g * 1024 + i], c_im[g * 1024 + i]};
    __syncthreads();
    for (int i = tid; i < 4096; i += NTHREADS) { const int tau = i >> 8, p = (i >> 4) & 15, q = i & 15; float s = 0.f;
        for (int n = 0; n < 64; ++n) { const f32x2 c = Cg[p * 64 + n], w = pw[tau * 64 + n], b = bb[n * 16 + q];
            const float xr = c.x * w.x - c.y * w.y, xi = c.x * w.y + c.y * w.x; s += xr * b.x - xi * b.y; }
        if (tau == 0 && p == q) s += d_skip[g * 16 + p];
        Kt[i] = s; }
    __syncthreads();
    for (int i = tid; i < 256 * 48; i += NTHREADS) { const int row = i / 48, ch = i % 48, t = row >> 4, p = row & 15, k0 = ch * 8; float v[8];
        if (k0 < 256) { const int j = k0 >> 4, q0 = k0 & 15;
#pragma unroll
            for (int e = 0; e < 8; ++e) v[e] = (j <= t) ? Kt[((t - j) * 16 + p) * 16 + q0 + e] : 0.f; }
        else {
#pragma unroll
            for (int e = 0; e < 8; ++e) { const int sidx = k0 - 256 + e, n = sidx & 63; const f32x2 c = Cg[p * 64 + n], w = pw[(t + 1) * 64 + n];
                v[e] = (sidx < 64) ? (c.x * w.x - c.y * w.y) : -(c.x * w.y + c.y * w.x); } }
        u32x4 o; o.x = cvt_pk_bf16(v[0], v[1]); o.y = cvt_pk_bf16(v[2], v[3]); o.z = cvt_pk_bf16(v[4], v[5]); o.w = cvt_pk_bf16(v[6], v[7]);
        *(u32x4*)(MT + (size_t)row * 384 + k0) = o; }
    for (int i = tid; i < 256 * 32; i += NTHREADS) { const int row = i >> 5, k0 = (i & 31) * 8, j = k0 >> 4, q0 = k0 & 15; float v[8];
#pragma unroll
        for (int e = 0; e < 8; ++e) { if (row < 128) { const int n = row & 63; const f32x2 w = pw[(15 - j) * 64 + n], b = bb[n * 16 + q0 + e];
                v[e] = (row < 64) ? (w.x * b.x - w.y * b.y) : (w.x * b.y + w.y * b.x); } else v[e] = 0.f; }
        u32x4 o; o.x = cvt_pk_bf16(v[0], v[1]); o.y = cvt_pk_bf16(v[2], v[3]); o.z = cvt_pk_bf16(v[4], v[5]); o.w = cvt_pk_bf16(v[6], v[7]);
        *(u32x4*)(W1s + (size_t)row * 256 + k0) = o; }
    __syncthreads();
}

__device__ __forceinline__ int moe_build_tiles(gu32* counts, LAS int* tt, int tid) {
    LAS int* cnt = tt + 1400; LAS int* st = cnt + 32; LAS int* tb = st + 33;
    if (tid < 32) cnt[tid] = (int)__hip_atomic_load(counts + tid, RLX_AGENT);
    __syncthreads();
    if (tid == 0) { int s = 0, b = 0;
        for (int e = 0; e < 32; ++e) { const int n = cnt[e]; if (s < HSPLIT && s + n > HSPLIT) s += (HSPLIT - s) & 255; st[e] = s; tb[e] = b; s += n; b += (n + 255) >> 8; }
        st[32] = s; tb[32] = b; }
    __syncthreads();
    if (tid < 32) { const int n = cnt[tid], s = st[tid], b = tb[tid]; const int k = (n + 255) >> 8;
        for (int m = 0; m < k; ++m) { const int nr = (n - m * 256) < 256 ? (n - m * 256) : 256; tt[2 * (b + m)] = tid | (nr << 8); tt[2 * (b + m) + 1] = s + m * 256; } }
    __syncthreads();
    return tb[32];
}

struct DownConvHook {
    static constexpr bool ON = true; static constexpr int I_E = 8 * 32, NDOWN = 32 * I_E;
    const float* p_wd; unsigned char* ws; gu32* cnt; int cls;
    __device__ __forceinline__ void pair(int lane) const {
        int u0 = 0; if (lane == 0) u0 = (int)__hip_atomic_fetch_add(cnt, 2u, RLX_AGENT);
        u0 = __builtin_amdgcn_readfirstlane(u0); if (u0 >= NDOWN) return;
        const int e = u0 / I_E, q = u0 % I_E;
        const TrJob ja{p_wd + (size_t)e * 1048576, nullptr, (bf16_t*)(ws + WS_WDT + (size_t)e * 1024 * 1024), 1024, 1024, (q / 32) * 128, (q % 32) * 32, -1, 1};
        TrJob jb = ja; jb.n0 += 32;
        const f32x4 s32 = (f32x4){32.f, 32.f, 32.f, 32.f}; const f32x4 sc[4] = {s32, s32, s32, s32};
        f32x4 va[16], vb[16]; transpose8_load(ja, lane, va); transpose8_load(jb, lane, vb);
        transpose8_store_sc(ja, lane, va, sc); transpose8_store_sc(jb, lane, vb, sc); }
    __device__ __forceinline__ void operator()(int ui) const {
        if ((ui & 3) != cls) return;
        int lane_ = threadIdx.x; asm volatile("" : "+v"(lane_)); pair(lane_ & 63); }
};

template <int PHM>
__global__ void __launch_bounds__(NTHREADS, 2) mk_fwd(Args args) {
    extern __shared__ __attribute__((aligned(16))) unsigned char lds_raw[];
    LAS unsigned char* lds = (LAS unsigned char*)lds_raw;
    volatile LAS unsigned* MISC = (volatile LAS unsigned*)(lds + LDS_MISC);
    const int tid = threadIdx.x, lane = tid & 63, wave = __builtin_amdgcn_readfirstlane(tid >> 6);
    const int G = gridDim.x; int bx = blockIdx.x; int vcu = (G % 8 == 0) ? (bx % 8) * (G / 8) + bx / 8 : bx;
    bool xl_ok = false; unsigned xl_x = 0u;
    unsigned char* ws = args.ws;
#define ctl ((gu32*)(ws + WS_CTL))
    if (tid < 64) MISC[tid] = 0u;
    __syncthreads();
    if (MK_N_LAUNCHES == 1) (void)xcd_barrier_post((unsigned*)(ws + WS_CTL) + CW_BAR, (volatile LAS unsigned*)(lds + LDS_MISC) + 8);
#define GRID_BAR() do { if (MK_N_LAUNCHES == 1) { XcdBarrier bar_; bar_.bar = (unsigned*)(ws + WS_CTL) + CW_BAR; bar_.x = xb_xcc_id(); bar_.st = (volatile LAS unsigned*)(lds + LDS_MISC) + 8; xcd_barrier(bar_); } } while (0)
#define SEAM_BAR(k) do { if (xl_ok) xcd_local_barrier((unsigned*)(ws + WS_CTL) + CW_BAR, xl_x, (unsigned)(G / 8) * (unsigned)(k)); else GRID_BAR(); } while (0)
#define IN(k) ((PHM >> (k)) & 1)
#define Xin ((const float*)INP(0))
#define rs1 ((float*)(ws + WS_RS1))
#define rs2 ((float*)(ws + WS_RS2))
#define tope ((int*)(ws + WS_TOPE))
#define topg ((float*)(ws + WS_TOPG))
#define spos ((int*)(ws + WS_SPOS))
#define srow ((int*)(ws + WS_SROW))
#define rtok ((int*)(ws + WS_RTOK))
#define rgate ((float*)(ws + WS_RGATE))
#define rrs ((float*)(ws + WS_RRS))
#define XB ((bf16_t*)(ws + WS_H1B))
#define H1b ((bf16_t*)(ws + WS_H1B))
#define WinT ((bf16_t*)(ws + WS_WINT))
#define WgluT ((bf16_t*)(ws + WS_WGLUT))
#define WaT ((bf16_t*)(ws + WS_WAT))
#define WoT ((bf16_t*)(ws + WS_WOT))
#define Wm ((bf16_t*)(ws + WS_WM))
#define AS5 ((bf16_t*)(ws + WS_AS5))
#define Ub ((bf16_t*)(ws + WS_U))
#define Vb ((bf16_t*)(ws + WS_V))
#define Zb ((bf16_t*)(ws + WS_Z))
#define YAB ((bf16_t*)(ws + WS_YAB))
#define GA ((bf16_t*)args.out)
#define GB ((bf16_t*)args.out + (size_t)T * 1024)
#define SST ((float*)(ws + WS_SST))
#define MRG ((bf16_t*)(ws + WS_MRG))
#define gw (vcu * NWAVES + wave)
#define NGW (G * NWAVES)

    if (IN(0)) {
        if (vcu < 32) s5_build_group(args, vcu, lds, tid);
        constexpr int I_IN = 8 * 16 * INP_NF8, I_INB = 16 * 16 * INP_NBF, I_IN8 = 8 * 64, I_GLU = 8 * 16, I_A = 8 * 32, I_B = 8 * 32, I_O = 16 * 32, I_E = 8 * 32;
        constexpr int NSMALL = I_INB + I_GLU + I_A + I_B + I_O, NITEMS = NSMALL + I_IN8 + I_IN, NXU = T / 2;
        const float *p_win = INP(2), *p_g1 = INP(1), *p_glu = INP(11), *p_wa = INP(17), *p_wb = INP(18), *p_wo = INP(19), *p_x = INP(0);
        auto mkjob = [&](int r) -> TrJob { TrJob j; constexpr int f8g[4] = INP_F8_GROUPS, bfg[4] = INP_BF_GROUPS;
            if (r < I_INB) { const int n0 = (r % (16 * INP_NBF)) * 32, gc = bfg[n0 >> 9] * 512 + (n0 & 511); j = TrJob{p_win + (gc - n0), p_g1, (bf16_t*)(ws + WS_WINT + (2u << 20)), INW, 1024, (r / (16 * INP_NBF)) * 64, n0, -1, 0}; return j; } r -= I_INB;
            if (r < I_GLU) { j = TrJob{p_glu, nullptr, WgluT, 512, 512, (r / 16) * 64, (r % 16) * 32, -1, 0}; return j; } r -= I_GLU;
            if (r < I_A) { j = TrJob{p_wa, nullptr, WaT, 1024, 1024, (r / 32) * 64, (r % 32) * 32, -1, 0}; return j; } r -= I_A;
            if (r < I_B) { j = TrJob{p_wb, nullptr, WaT + 512, 1024, 1024, (r / 32) * 64, (r % 32) * 32, -1, 0}; return j; } r -= I_B;
            if (r < I_O) { j = TrJob{p_wo, nullptr, WoT, 1024, 1024, (r / 32) * 64, (r % 32) * 32, -1, 0}; return j; } r -= I_O;
            if (r < I_IN) { const int n0 = (r % (16 * INP_NF8)) * 32, gc = f8g[n0 >> 9] * 512 + (n0 & 511); j = TrJob{p_win + (gc - n0), p_g1, WinT, INW, 1024, (r / (16 * INP_NF8)) * 128, n0, -1, 1}; return j; } r -= I_IN;
            const int nb = r % 64; j = TrJob{p_win + (nb < 32 ? 1536 : 2560), p_g1, (bf16_t*)(ws + WS_WINT8), INW, 1024, (r / 64) * 128, (nb & 31) * 32, nb < 32 ? 0 : 128, 1}; return j; };
        for (;;) {
            int u0 = 0; if (lane == 0) u0 = (int)__hip_atomic_fetch_add(ctl + CW_CNT + 64, 4u, RLX_AGENT);
            u0 = __builtin_amdgcn_readfirstlane(u0); if (u0 >= NITEMS) break;
            for (int p = 0; p < 4; p += 2) { const int i0 = u0 + p, i1 = i0 + 1;
                if (i0 < NSMALL) { const TrJob ja = mkjob(i0), jb = mkjob(i1); f32x4 va[8], vb[8]; transpose_load(ja, lane, va); transpose_load(jb, lane, vb); transpose_store(ja, lane, va); transpose_store(jb, lane, vb); }
                else { const TrJob ja = mkjob(i0), jb = mkjob(i1); f32x4 va[16], vb[16]; transpose8_load(ja, lane, va); transpose8_load(jb, lane, vb); transpose8_store(ja, lane, va); transpose8_store(jb, lane, vb); } }
        }
        for (;;) {
            int u0 = 0; if (lane == 0) u0 = (int)__hip_atomic_fetch_add(ctl + CW_CNT + 192, 8u, RLX_AGENT);
            u0 = __builtin_amdgcn_readfirstlane(u0); if (u0 >= NXU) break;
            for (int p = 0; p < 8; p += 2) { const int m = (p >> 1) * (T / 4) + (u0 >> 1);
                const f32x4* xr = (const f32x4*)(p_x + (size_t)m * D) + 2 * lane; f32x4 v[16]; float s[4] = {0.f, 0.f, 0.f, 0.f};
#pragma unroll
                for (int q = 0; q < 4; ++q)
#pragma unroll
                    for (int j = 0; j < 2; ++j) { v[4 * q + 2 * j] = __builtin_nontemporal_load(xr + 256 * q + 128 * j); v[4 * q + 2 * j + 1] = __builtin_nontemporal_load(xr + 256 * q + 128 * j + 1); }
#pragma unroll
                for (int q = 0; q < 4; ++q)
#pragma unroll
                    for (int j = 0; j < 4; ++j) { const f32x4 w = v[4 * q + j]; s[q] += (w.x * w.x + w.y * w.y) + (w.z * w.z + w.w * w.w); }
#pragma unroll
                for (int o = 1; o < 64; o <<= 1) { s[0] += __shfl_xor(s[0], o); s[1] += __shfl_xor(s[1], o); s[2] += __shfl_xor(s[2], o); s[3] += __shfl_xor(s[3], o); }
                if (lane < 4) { const float sv = lane == 0 ? s[0] : (lane == 1 ? s[1] : (lane == 2 ? s[2] : s[3])); rs1[m + lane] = 1.0f / sqrtf(sv * (1.0f / D) + NORM_EPS); }
                u32x4* o = (u32x4*)(XB + (size_t)m * D) + lane; u32x2* o8 = (u32x2*)(ws + WS_H1F8 + (size_t)m * D) + lane;
#pragma unroll
                for (int q = 0; q < 4; ++q)
#pragma unroll
                    for (int j = 0; j < 2; ++j) { const f32x4 w0 = v[4 * q + 2 * j], w1 = v[4 * q + 2 * j + 1]; o[128 * q + 64 * j] = pack8(w0, w1); o8[128 * q + 64 * j] = pack8_f8(w0, w1); } }
        }
        { const float* bgp = INP(24); const float* bup_ = INP(26); const float* bdp = INP(28); const float* blp = INP(12);
          for (int i = vcu * NTHREADS + tid; i < 32768; i += G * NTHREADS) { ((float*)(ws + WS_BG))[i] = bgp[i] * MOE_KSG; ((float*)(ws + WS_BU))[i] = (bup_[i] + 1.0f) * (1.0f / MOE_KSG); ((float*)(ws + WS_BD))[i] = bdp[i]; if (i < 512) ((float*)(ws + WS_BGLU))[i] = blp[i];
              if (i < 16384) { const int kp = i >> 5, e = i & 31; const float* wr_ = INP(21); const float* g2 = INP(20); const float w0 = wr_[(2 * kp) * 32 + e] * g2[2 * kp], w1 = wr_[(2 * kp + 1) * 32 + e] * g2[2 * kp + 1];
                  const unsigned hi = cvt_pk_bf16(w0, w1); const unsigned lo = cvt_pk_bf16(w0 - bflo(hi), w1 - bfhi(hi));
                  *(unsigned*)(ws + WS_WRIMG + e * 2064 + 4 * kp) = hi; *(unsigned*)(ws + WS_WRIMG + 32 * 2064 + e * 2064 + 4 * kp) = lo; }
              if (i < 1024) { const float g2v = INP(20)[i]; ((float*)(ws + WS_G2S))[i] = g2v * MOE_KSG; ((float*)(ws + WS_G2S))[1024 + i] = g2v * (1.0f / MOE_KSG); } } }
        for (int i = vcu * NTHREADS + tid; i < 4 * 128 * 128; i += G * NTHREADS) { const int ii = (i >> 7) & 127, jj = i & 127; const float w = ((ii >> 6) >= (jj >> 6)) ? INP(15)[i] : 0.f; Wm[i] = (bf16_t)(cvt_pk_bf16(w, 0.f) & 0xffffu); }
        GRID_BAR();
        if (MK_N_LAUNCHES == 1 && __builtin_amdgcn_readfirstlane((int)MISC[10]) != 0) {
            xl_ok = true; xl_x = xb_xcc_id(); const int rk = __builtin_amdgcn_readfirstlane((int)MISC[11]);
            bx = rk * 8 + (int)xl_x; vcu = (int)xl_x * (G / 8) + rk; }
    }

    if (IN(1)) {
        constexpr int f8g[4] = INP_F8_GROUPS, bfg[4] = INP_BF_GROUPS;
        constexpr int I_E = 8 * 32, NMOE = 64 * I_E, GRABM = 4, QUOTA = 2;
        const int cls = (G == 256) ? ((bx >> 3) & 3) : 3;
#pragma unroll 1
        for (int stage = 0; stage < 4; ++stage) {
            const int quota = stage == 3 ? (1 << 30) : (stage == cls ? QUOTA : 0);
            if (quota > 0) { int lane_ = threadIdx.x; asm volatile("" : "+v"(lane_)); const int lane = lane_ & 63;
        const float *p_g2 = (const float*)(ws + WS_G2S), *p_wg = INP(23), *p_wu = INP(25), *p_wd = INP(27);
            auto mkmoe = [&](int r) -> TrJob { TrJob j; const int ty = r / (32 * I_E), e = (r / I_E) % 32, q = r % I_E, k0 = (q / 32) * 128, n0 = (q % 32) * 32;
                if (ty == 0) j = TrJob{p_wg + (size_t)e * 1048576, p_g2, (bf16_t*)(ws + WS_W1T + (size_t)e * 2048 * 1024), 1024, 1024, k0, n0, 0, 1};
                else if (ty == 1) j = TrJob{p_wu + (size_t)e * 1048576, p_g2 + 1024, (bf16_t*)(ws + WS_W1T + (size_t)e * 2048 * 1024), 1024, 1024, k0, n0, 128, 1};
                else j = TrJob{p_wd + (size_t)e * 1048576, nullptr, (bf16_t*)(ws + WS_WDT + (size_t)e * 1024 * 1024), 1024, 1024, k0, n0, -1, 1};
                return j; };
            for (int gq = 0; gq < quota; ++gq) {
                int u0 = 0; if (lane == 0) u0 = (int)__hip_atomic_fetch_add(ctl + CW_CNT + 128, (unsigned)GRABM, RLX_AGENT);
                u0 = __builtin_amdgcn_readfirstlane(u0); if (u0 >= NMOE) break;
                const TrJob j0 = mkmoe(u0); f32x4 sc[4];
#pragma unroll
                for (int q = 0; q < 4; ++q) sc[q] = (j0.ks ? *(const f32x4*)(j0.ks + j0.k0 + 16 * (lane >> 3) + 4 * q) : (f32x4){1.f, 1.f, 1.f, 1.f}) * 32.0f;
                for (int p = 0; p < GRABM; p += 2) { const TrJob ja = mkmoe(u0 + p), jb = mkmoe(u0 + p + 1); f32x4 va[16], vb[16]; transpose8_load(ja, lane, va); transpose8_load(jb, lane, vb);
                    transpose8_store_sc(ja, lane, va, sc); transpose8_store_sc(jb, lane, vb, sc); } } }
            __syncthreads();
            if (stage == 0) { if (INP_NBF > 0) { pg8::DenseSched S; S.init(WS_H1B, WS_WINT + (2u << 20), T, 512 * INP_NBF, D, D, G, bx);
                int pm_ = 0; for (int q = 0; q < 2 * INP_NBF; ++q) pm_ |= (2 * bfg[q >> 1] + (q & 1)) << (4 * q);
                pg8::EpiInProj E{AS5, Ub, Vb, pm_, 1.0f};
                pg8::gemm_phase(lds, ws, S, E); } }
            else if (stage == 1) { if (INP_NF8 > 0) { pg8::DenseSchedT<true> S; S.init(WS_H1F8, WS_WINT, T, 512 * INP_NF8, D, D, G, bx);
                int pm_ = 0; for (int q = 0; q < 2 * INP_NF8; ++q) pm_ |= (2 * f8g[q >> 1] + (q & 1)) << (4 * q);
                pg8::EpiInProj E{AS5, Ub, Vb, pm_, 0.03125f};
                pg8::gemm_phase(lds, ws, S, E); } }
            else if (stage == 2) { pg8::DenseSchedT<true> S; S.init(WS_H1F8, WS_WINT8, T, 2048, D, D, G, bx);
                pg8::EpiGates E{GA, GB};
                pg8::gemm_phase(lds, ws, S, E); }
        }
        GRID_BAR();
    }

    if (IN(2)) {
        { pg8::S5Sched S; S.init(WS_AS5, WS_W1S, 256, vcu); pg8::EpiS5End E{SST}; pg8::gemm_phase(lds, ws, S, E); }

        for (int item = vcu; item < 256; item += G) {
            const int t0 = item * 128; constexpr int RS = 1056;
            const float* lng = INP(13); const float* lnb = INP(14); const float* bs = INP(16);
            const f32x4 g0 = *(const f32x4*)(lng + lane * 8), g1 = *(const f32x4*)(lng + lane * 8 + 4), b0 = *(const f32x4*)(lnb + lane * 8), b1 = *(const f32x4*)(lnb + lane * 8 + 4);
            u32x4 raw[16]; float sm[16], sq[16];
#pragma unroll
            for (int r = 0; r < 16; ++r) raw[r] = *(const u32x4*)(Vb + (size_t)(t0 + wave * 16 + r) * 512 + lane * 8);
#pragma unroll
            for (int r = 0; r < 16; ++r) { f32x4 v0, v1; unpack8(raw[r], v0, v1); sm[r] = (v0[0] + v0[1]) + (v0[2] + v0[3]) + (v1[0] + v1[1]) + (v1[2] + v1[3]); }
#pragma unroll
            for (int o = 1; o < 64; o <<= 1)
#pragma unroll
                for (int r = 0; r < 16; ++r) sm[r] += __shfl_xor(sm[r], o);
#pragma unroll
            for (int r = 0; r < 16; ++r) { f32x4 v0, v1; unpack8(raw[r], v0, v1); const float mean = sm[r] * (1.0f / 512.0f); v0 -= mean; v1 -= mean;
                sq[r] = (v0[0] * v0[0] + v0[1] * v0[1]) + (v0[2] * v0[2] + v0[3] * v0[3]) + (v1[0] * v1[0] + v1[1] * v1[1]) + (v1[2] * v1[2] + v1[3] * v1[3]); }
#pragma unroll
            for (int o = 1; o < 64; o <<= 1)
#pragma unroll
                for (int r = 0; r < 16; ++r) sq[r] += __shfl_xor(sq[r], o);
#pragma unroll
            for (int r = 0; r < 16; ++r) { f32x4 v0, v1; unpack8(raw[r], v0, v1); const float mean = sm[r] * (1.0f / 512.0f), rstd = 1.0f / sqrtf(sq[r] * (1.0f / 512.0f) + NORM_EPS);
                v0 = (v0 - mean) * rstd * g0 + b0; v1 = (v1 - mean) * rstd * g1 + b1;
                *(LAS u32x4*)(lds + (wave * 16 + r) * RS + lane * 16) = pack8(v0, v1); }
            __syncthreads();
            const int i0 = wave * 16, fr = lane & 15, fq = lane >> 4;
            bf16x8 wf[4], wn[4]; u32x4 uf[4], un[4];
            const bf16_t* urow = Ub + (size_t)(t0 + i0 + fr) * 512 + (fq & 1) * 16 + 8 * (fq >> 1);
#pragma unroll
            for (int ks = 0; ks < 4; ++ks) wf[ks] = *(const bf16x8*)(Wm + ((size_t)0 * 128 + i0 + fr) * 128 + ks * 32 + fq * 8);
#pragma unroll
            for (int j = 0; j < 4; ++j) uf[j] = *(const u32x4*)(urow + j * 32);
            for (int h = 0; h < 4; ++h) {
                const int hn = h < 3 ? h + 1 : 3;
#pragma unroll
                for (int ks = 0; ks < 4; ++ks) wn[ks] = *(const bf16x8*)(Wm + ((size_t)hn * 128 + i0 + fr) * 128 + ks * 32 + fq * 8);
#pragma unroll
                for (int j = 0; j < 4; ++j) un[j] = *(const u32x4*)(urow + hn * 128 + j * 32);
                const float bias = bs[h * 128 + i0 + fr];
#pragma unroll
                for (int j = 0; j < 4; ++j) { u32x2 o2[2];
                    const auto s0 = __builtin_amdgcn_permlane16_swap(uf[j].x, uf[j].z, false, false), s1 = __builtin_amdgcn_permlane16_swap(uf[j].y, uf[j].w, false, false);
                    const u32x2 uw2[2] = {(u32x2){s0[0], s1[0]}, (u32x2){s0[1], s1[1]}};
#pragma unroll
                    for (int q = 0; q < 2; ++q) { const int cb = 2 * j + q; f32x4 a = (f32x4){0.f, 0.f, 0.f, 0.f}; const int c0 = h * 128 + cb * 16;
#pragma unroll
                        for (int ks = 0; ks < 4; ++ks) {
                            const LAS unsigned char* p = lds + (ks * 32 + fq * 8 + (fr >> 2)) * RS + (c0 + 4 * (fr & 3)) * 2;
                            const s16x4 lo4 = __builtin_bit_cast(s16x4, __builtin_amdgcn_ds_read_tr16_b64_v4i16((LAS s16x4*)p));
                            const s16x4 hi4 = __builtin_bit_cast(s16x4, __builtin_amdgcn_ds_read_tr16_b64_v4i16((LAS s16x4*)(p + 4 * RS)));
                            const bf16x8 vf = (bf16x8){lo4[0], lo4[1], lo4[2], lo4[3], hi4[0], hi4[1], hi4[2], hi4[3]};
                            a = __builtin_amdgcn_mfma_f32_16x16x32_bf16(vf, wf[ks], a, 0, 0, 0); }
                        o2[q].x = cvt_pk_bf16(bflo(uw2[q].x) * (a[0] + bias), bfhi(uw2[q].x) * (a[1] + bias)); o2[q].y = cvt_pk_bf16(bflo(uw2[q].y) * (a[2] + bias), bfhi(uw2[q].y) * (a[3] + bias)); }
                    *(u32x4*)(YAB + (size_t)(t0 + i0 + fr) * 1024 + 512 + h * 128 + (2 * j + (fq & 1)) * 16 + 8 * (fq >> 1)) = pair16_f8(o2[0], o2[1]); }
#pragma unroll
                for (int ks = 0; ks < 4; ++ks) wf[ks] = wn[ks];
#pragma unroll
                for (int j = 0; j < 4; ++j) uf[j] = un[j];
            }
            __syncthreads();
        }

        SEAM_BAR(1);
    }

    if (IN(3)) {
        for (int item = vcu; item < 256; item += G) {
            const int g = item >> 3, b = (item >> 1) & 3, nh = item & 1;
            LAS float* sm = (LAS float*)lds;
            LAS f32x2* Eb = (LAS f32x2*)(lds + 131072);
            { f32x4 t[16];
#pragma unroll
              for (int j = 0; j < 16; ++j) { const int i = tid + j * NTHREADS, c = i >> 4, part = (i >> 3) & 1, q = i & 7; t[j] = *(const f32x4*)(SST + (size_t)(b * 512 + c) * 4096 + g * 128 + part * 64 + nh * 32 + q * 4); }
#pragma unroll
              for (int j = 0; j < 16; ++j) { const int i = tid + j * NTHREADS, c = i >> 4, part = (i >> 3) & 1, q = i & 7; *(LAS f32x4*)(sm + c * 64 + part * 32 + q * 4) = t[j]; } }
            __syncthreads();
            const int seg = tid >> 5, nl = tid & 31, n = nh * 32 + nl; const f32x2* lamtab = (const f32x2*)(ws + WS_LAM);
            const f32x2 l16 = lamtab[g * 64 + n], l512 = lamtab[2048 + g * 64 + n];
            float sr = 0.f, si = 0.f;
            for (int c = seg * 32; c < seg * 32 + 32; ++c) { const float xr = sm[c * 64 + nl], xi = sm[c * 64 + 32 + nl]; const float tr = l16.x * sr - l16.y * si + xr, ti = l16.x * si + l16.y * sr + xi; sr = tr; si = ti; }
            Eb[seg * 32 + nl] = (f32x2){sr, si};
            __syncthreads();
            sr = 0.f; si = 0.f;
            for (int s = 0; s < seg; ++s) { const f32x2 e = Eb[s * 32 + nl]; const float tr = l512.x * sr - l512.y * si + e.x, ti = l512.x * si + l512.y * sr + e.y; sr = tr; si = ti; }
            for (int c = seg * 32; c < seg * 32 + 32; ++c) {
                const float xr = sm[c * 64 + nl], xi = sm[c * 64 + 32 + nl]; sm[c * 64 + nl] = sr; sm[c * 64 + 32 + nl] = si;
                const float tr = l16.x * sr - l16.y * si + xr, ti = l16.x * si + l16.y * sr + xi; sr = tr; si = ti; }
            __syncthreads();
            { bf16_t* dst = AS5 + ((size_t)g * 2048 + (size_t)b * 512) * AS5_LD + 256 + nh * 32;
#pragma unroll
              for (int j = 0; j < 8; ++j) { const int p = tid + j * NTHREADS, c = p >> 3, sub = p & 7; const LAS float* sp = sm + c * 64 + (sub >> 2) * 32 + (sub & 3) * 8;
                  *(u32x4*)(dst + (size_t)c * AS5_LD + (sub >> 2) * 64 + (sub & 3) * 8) = pack8(*(const LAS f32x4*)sp, *(const LAS f32x4*)(sp + 4)); } }
            __syncthreads();
        }
        SEAM_BAR(2);
    }

    if (IN(4)) {
        pg8::S5Sched S; S.init(WS_AS5, WS_MT, 384, vcu); pg8::EpiS5Out E{Zb}; pg8::gemm_phase(lds, ws, S, E);
        GRID_BAR();
    }
    if (IN(5)) {
        pg8::DenseSched S; S.init(WS_Z, WS_WGLUT, T, 512, 512, 512, G, bx); pg8::EpiGlu E{Zb, INP(12), YAB}; pg8::gemm_phase(lds, ws, S, E);
        SEAM_BAR(3);
    }
    if (IN(6)) {
        pg8::DenseSched S; S.init(WS_YAB, WS_WAT, T, D, D, D, G, bx); pg8::EpiMerge E{GA, GB, MRG}; pg8::gemm_phase(lds, ws, S, E);
        SEAM_BAR(4);
    }
    if (IN(7)) {
        pg8::DenseSched S; S.init(WS_MRG, WS_WOT, T, D, D, D, G, bx); pg8::EpiOutProj E{H1b, ws + WS_H1F8}; pg8::gemm_phase(lds, ws, S, E);
        SEAM_BAR(5);
    }
    if (IN(8)) {
        constexpr int WRS = 2064;
        LAS unsigned char* WRhi = lds; LAS unsigned char* WRlo = lds + 32 * WRS;
        LAS int* hist = (LAS int*)(lds + LDS_X + 20480); LAS int* hbase = hist + 32;
        { const u32x4* img = (const u32x4*)(ws + WS_WRIMG) + tid; u32x4 t[16], tl = (u32x4){0u, 0u, 0u, 0u};
#pragma unroll
          for (int j = 0; j < 16; ++j) t[j] = img[j * NTHREADS];
          if (tid < 132096 / 16 - 16 * NTHREADS) tl = img[16 * NTHREADS];
#pragma unroll
          for (int j = 0; j < 16; ++j) *(LAS u32x4*)(lds + (tid + j * NTHREADS) * 16) = t[j];
          if (tid < 132096 / 16 - 16 * NTHREADS) *(LAS u32x4*)(lds + (tid + 16 * NTHREADS) * 16) = tl; }
        if (tid < 32) hist[tid] = 0;
        __syncthreads();
        const float* brt = INP(22);
        for (int blk = vcu; blk < 256; blk += G) {
            int e4[4] = {0, 0, 0, 0}, lp4[4] = {0, 0, 0, 0}; float gt4[4] = {0.f, 0.f, 0.f, 0.f}, rsv = 0.f; const int tok0 = blk * 128 + wave * 32; const int hi = lane >> 5, li = lane & 31;
            if (wave < 4) {
                LAS float* scr = (LAS float*)(lds + 132096 + wave * 4608);
                const bf16_t* hrow = H1b + (size_t)(tok0 + li) * 1024 + 8 * hi;
                const LAS unsigned char* bh = WRhi + li * WRS + 16 * hi; const LAS unsigned char* bl = WRlo + li * WRS + 16 * hi;
                f32x16 acc; for (int r = 0; r < 16; ++r) acc[r] = 0.f; float ssq = 0.f;
#pragma unroll 8
                for (int s = 0; s < 64; ++s) { const u32x4 av = *(const u32x4*)(hrow + 16 * s);
                    ssq += (bflo(av.x) * bflo(av.x) + bfhi(av.x) * bfhi(av.x)) + (bflo(av.y) * bflo(av.y) + bfhi(av.y) * bfhi(av.y)) + (bflo(av.z) * bflo(av.z) + bfhi(av.z) * bfhi(av.z)) + (bflo(av.w) * bflo(av.w) + bfhi(av.w) * bfhi(av.w));
                    const bf16x8 a = __builtin_bit_cast(bf16x8, av);
                    acc = __builtin_amdgcn_mfma_f32_32x32x16_bf16(a, *(const LAS bf16x8*)(bh + 32 * s), acc, 0, 0, 0);
                    acc = __builtin_amdgcn_mfma_f32_32x32x16_bf16(a, *(const LAS bf16x8*)(bl + 32 * s), acc, 0, 0, 0); }
                ssq += __shfl_xor(ssq, 32);
#pragma unroll
                for (int r = 0; r < 16; ++r) scr[((r & 3) + 8 * (r >> 2) + 4 * hi) * 33 + li] = acc[r];
                LDS_WAIT(); asm volatile("" ::: "memory");
                if (lane < 32) { const float rs = 1.0f / sqrtf(ssq * (1.0f / 1024.0f) + NORM_EPS); rsv = rs;
                    float v4[4]; int i0 = -1, i1 = -1, i2 = -1;
#pragma unroll
                    for (int k = 0; k < 4; ++k) { float best = -INFINITY; int bi = 0;
                        for (int e = 0; e < 32; ++e) { const float l = scr[lane * 33 + e] * rs + brt[e]; const bool ok = (e != i0) && (e != i1) && (e != i2); if (ok && l > best) { best = l; bi = e; } }
                        v4[k] = best; e4[k] = bi; if (k == 0) i0 = bi; else if (k == 1) i1 = bi; else if (k == 2) i2 = bi; }
                    const float p1 = __expf(v4[1] - v4[0]), p2 = __expf(v4[2] - v4[0]), p3 = __expf(v4[3] - v4[0]); const float inv = 1.0f / (1.0f + p1 + p2 + p3);
                    gt4[0] = inv; gt4[1] = p1 * inv; gt4[2] = p2 * inv; gt4[3] = p3 * inv;
#pragma unroll
                    for (int k = 0; k < 4; ++k) lp4[k] = __hip_atomic_fetch_add((int*)(hist + e4[k]), 1, __ATOMIC_RELAXED, __HIP_MEMORY_SCOPE_WORKGROUP); }
            }
            __syncthreads();
            if (tid < 32) { const int c = hist[tid]; hbase[tid] = c ? (int)__hip_atomic_fetch_add(ctl + CW_CNT + tid, (unsigned)c, RLX_AGENT) : 0; hist[tid] = 0; }
            __syncthreads();
            if (wave < 4 && lane < 32) { const int t = tok0 + lane;
#pragma unroll
                for (int k = 0; k < 4; ++k) { const int pos = hbase[e4[k]] + lp4[k], ix = e4[k] * T + pos; lp4[k] = pos;
                    ((int*)(ws + WS_RT2))[ix] = t; ((float*)(ws + WS_RG2))[ix] = gt4[k]; ((float*)(ws + WS_RR2))[ix] = rsv; }
                *(int4*)(tope + t * 4) = make_int4(e4[0], e4[1], e4[2], e4[3]); *(int4*)(spos + t * 4) = make_int4(lp4[0], lp4[1], lp4[2], lp4[3]); }
            __syncthreads();
        }
        GRID_BAR();
    }
    if (IN(10)) {
        LAS int* tt = (LAS int*)(lds + LDS_X); const int ntiles = moe_build_tiles(ctl + CW_CNT, tt, tid);
        pg8::MoeSched1 S; S.A = (unsigned)WS_H1F8; S.Bt = (unsigned)WS_W1T; S.rtk = (const int*)(ws + WS_RT2); S.tt = tt; S.lda2 = 1024u; S.K2 = 1024u; S.hstepA = 0u; S.nt = 8; S.ntiles = ntiles; S.G = G; S.vc = vcu;
        pg8::EpiMoe1 E{rrs, INP(24), INP(26), ws + WS_HWS, ws + WS_TRASH};
        const DownConvHook H{INP(27), ws, ctl + CW_CNT + 160, (vcu >> 3) & 3};
        pg8::gemm_phase(lds, ws, S, E, H);
        { int lane_ = threadIdx.x; asm volatile("" : "+v"(lane_)); const int ln = lane_ & 63;
          while (__hip_atomic_load(ctl + CW_CNT + 160, RLX_AGENT) < (unsigned)DownConvHook::NDOWN) H.pair(ln); }
        GRID_BAR();
    }
    if (IN(11)) {
        LAS int* tt = (LAS int*)(lds + LDS_X); const int ntiles = moe_build_tiles(ctl + CW_CNT, tt, tid);
        pg8::MoeSched2 S; S.Ahi = (unsigned)WS_HWS; S.Bt = (unsigned)WS_WDT; S.tt = tt; S.lda2 = 1024u; S.K2 = 1024u; S.hstepA = 128u * 1024u; S.nt = 8; S.ntiles = ntiles; S.G = G; S.vc = vcu;
        pg8::EpiMoe2 E{rgate, INP(28), ws + WS_Y, ws + WS_TRASH}; pg8::gemm_phase(lds, ws, S, E);
        GRID_BAR();
    }
    if (IN(12)) {
        LAS int* ttf = (LAS int*)(lds + LDS_X); (void)moe_build_tiles(ctl + CW_CNT, ttf, tid); const LAS int* st = ttf + 1432;
        const float* gf = INP(29);
        const f32x4 gf0 = *(const f32x4*)(gf + lane * 8), gf1 = *(const f32x4*)(gf + lane * 8 + 4), gf2 = *(const f32x4*)(gf + 512 + lane * 8), gf3 = *(const f32x4*)(gf + 512 + lane * 8 + 4);
        u32x4 cur[2], nxt[2]; u32x2 ycur[8], ynxt[8];
#define P12_LOAD(dst, ydst, tt) do { const int4 te_ = *(const int4*)(tope + (size_t)(tt) * 4), sp_ = *(const int4*)(spos + (size_t)(tt) * 4); const int r0_ = __builtin_amdgcn_readfirstlane(st[te_.x] + sp_.x), r1_ = __builtin_amdgcn_readfirstlane(st[te_.y] + sp_.y), r2_ = __builtin_amdgcn_readfirstlane(st[te_.z] + sp_.z), r3_ = __builtin_amdgcn_readfirstlane(st[te_.w] + sp_.w); \
            const unsigned char* Y8_ = ws + WS_Y + lane * 8; \
            dst[0] = __builtin_nontemporal_load((const u32x4*)(H1b + (size_t)(tt) * 1024 + lane * 8)); dst[1] = __builtin_nontemporal_load((const u32x4*)(H1b + (size_t)(tt) * 1024 + 512 + lane * 8)); \
            ydst[0] = __builtin_nontemporal_load((const u32x2*)(Y8_ + (size_t)r0_ * 1024)); ydst[1] = __builtin_nontemporal_load((const u32x2*)(Y8_ + (size_t)r0_ * 1024 + 512)); \
            ydst[2] = __builtin_nontemporal_load((const u32x2*)(Y8_ + (size_t)r1_ * 1024)); ydst[3] = __builtin_nontemporal_load((const u32x2*)(Y8_ + (size_t)r1_ * 1024 + 512)); \
            ydst[4] = __builtin_nontemporal_load((const u32x2*)(Y8_ + (size_t)r2_ * 1024)); ydst[5] = __builtin_nontemporal_load((const u32x2*)(Y8_ + (size_t)r2_ * 1024 + 512)); \
            ydst[6] = __builtin_nontemporal_load((const u32x2*)(Y8_ + (size_t)r3_ * 1024)); ydst[7] = __builtin_nontemporal_load((const u32x2*)(Y8_ + (size_t)r3_ * 1024 + 512)); } while (0)
#define P12_ADD8(w, lo4, hi4) do { const f32x2 q0_ = __builtin_amdgcn_cvt_pk_f32_fp8((int)(w).x, false), q1_ = __builtin_amdgcn_cvt_pk_f32_fp8((int)(w).x, true), q2_ = __builtin_amdgcn_cvt_pk_f32_fp8((int)(w).y, false), q3_ = __builtin_amdgcn_cvt_pk_f32_fp8((int)(w).y, true); \
            lo4 += (f32x4){q0_.x, q0_.y, q1_.x, q1_.y} * 0.0625f; hi4 += (f32x4){q2_.x, q2_.y, q3_.x, q3_.y} * 0.0625f; } while (0)
        int t = gw;
        if (t < T) P12_LOAD(cur, ycur, t);
        for (; t < T; t += NGW) {
            const int tn = t + NGW; const bool hn = tn < T;
            if (hn) P12_LOAD(nxt, ynxt, tn);
            f32x4 a0, a1, a2, a3; unpack8(cur[0], a0, a1); unpack8(cur[1], a2, a3);
#pragma unroll
            for (int k = 0; k < 4; ++k) { P12_ADD8(ycur[2 * k], a0, a1); P12_ADD8(ycur[2 * k + 1], a2, a3); }
            float s = 0.f;
#pragma unroll
            for (int j = 0; j < 4; ++j) s += a0[j] * a0[j] + a1[j] * a1[j] + a2[j] * a2[j] + a3[j] * a3[j];
            const float rs = 1.0f / sqrtf(wave_sum(s) * (1.0f / 1024.0f) + NORM_EPS);
            float* o = args.out + (size_t)t * 1024 + lane * 8;
            __builtin_nontemporal_store(a0 * rs * gf0, (f32x4*)o); __builtin_nontemporal_store(a1 * rs * gf1, (f32x4*)(o + 4)); __builtin_nontemporal_store(a2 * rs * gf2, (f32x4*)(o + 512)); __builtin_nontemporal_store(a3 * rs * gf3, (f32x4*)(o + 516));
            if (hn) { cur[0] = nxt[0]; cur[1] = nxt[1];
#pragma unroll
                for (int i = 0; i < 8; ++i) ycur[i] = ynxt[i]; }
        }
#undef P12_ADD8
#undef P12_LOAD
    }
#undef IN
#undef GRID_BAR
}

typedef void (*kern_t)(Args);
template <int P> static void get_kerns(kern_t* k) { k[P] = mk_fwd<(1 << P)>; if constexpr (P > 0) get_kerns<P - 1>(k); }
extern "C" void kernel_launch(void* const* d_in, const int* in_sizes, int n_in, void* d_out, int out_size, void* d_ws, size_t ws_size, hipStream_t stream) {
    static int grid = 0; static kern_t kerns[NPHASE + 1];
    if (grid == 0) {
        if (n_in != 30 || in_sizes[0] != T * D || out_size != T * D || ws_size < WS_END) { fprintf(stderr, "kernel_launch: unexpected shapes / workspace (n_in %d, ws %zu)\n", n_in, ws_size); grid = -1; return; }
        int dev = 0, cus = 0, per_cu = 0;
        if (hipGetDevice(&dev) != hipSuccess || hipDeviceGetAttribute(&cus, hipDeviceAttributeMultiprocessorCount, dev) != hipSuccess) { grid = -1; return; }
#ifdef ONLY_PH
        kerns[ONLY_PH] = mk_fwd<(1 << ONLY_PH)>;
#else
        if constexpr (MK_N_LAUNCHES == 1) kerns[NPHASE] = mk_fwd<(1 << NPHASE) - 1>; else get_kerns<NPHASE - 1>(kerns);
#endif
        for (int p = 0; p <= NPHASE; ++p) if (kerns[p]) {
            if (hipFuncSetAttribute((const void*)kerns[p], hipFuncAttributeMaxDynamicSharedMemorySize, LDS_BYTES) != hipSuccess) { fprintf(stderr, "kernel_launch: hipFuncSetAttribute failed\n"); grid = -1; return; }
            if (hipOccupancyMaxActiveBlocksPerMultiprocessor(&per_cu, (const void*)kerns[p], NTHREADS, LDS_BYTES) != hipSuccess || per_cu < 1) { fprintf(stderr, "kernel_launch: occupancy query reports %d for kernel %d\n", per_cu, p); } }
        (void)hipGetLastError();
        grid = cus;
    }
    if (grid < 0) return;
    (void)hipMemsetAsync((char*)d_ws + WS_CTL, 0, CTL_ZERO_BYTES, stream);
    Args a{};
    for (int i = 0; i < 30; ++i) a.in[i] = (const float*)d_in[i];
    a.out = (float*)d_out; a.ws = (unsigned char*)d_ws;
    if (MK_N_LAUNCHES == 1) { a.ph_lo = 0; a.ph_hi = NPHASE; hipLaunchKernelGGL(kerns[NPHASE], dim3(grid), dim3(NTHREADS), LDS_BYTES, stream, a); }
    else for (int p = 0; p < NPHASE; ++p) { a.ph_lo = p; a.ph_hi = p + 1; hipLaunchKernelGGL(kerns[p], dim3(grid), dim3(NTHREADS), LDS_BYTES, stream, a); }
}
```

```cpp
#include <hip/hip_runtime.h>
#include <cstdio>
#include <cstdint>

#ifndef MK_N_LAUNCHES
#define MK_N_LAUNCHES 1
#endif

#define LAS __attribute__((address_space(3)))
#define GAS __attribute__((address_space(1)))
typedef unsigned short bf16_t;
typedef short bf16x8 __attribute__((ext_vector_type(8)));
typedef float f32x4 __attribute__((ext_vector_type(4)));
typedef float f32x2 __attribute__((ext_vector_type(2)));
typedef float f32x16 __attribute__((ext_vector_type(16)));
typedef unsigned u32x4 __attribute__((ext_vector_type(4)));
typedef unsigned u32x2 __attribute__((ext_vector_type(2)));
typedef short s16x4 __attribute__((ext_vector_type(4)));
typedef int i32x4 __attribute__((ext_vector_type(4)));
typedef int i32x8 __attribute__((ext_vector_type(8)));
typedef GAS unsigned gu32;

constexpr int T = 32768, D = 1024, INW = 3584, NE = 32;
constexpr int AS5_LD = 384;
constexpr float NORM_EPS = 1e-5f;
constexpr int NWAVES = 8, NTHREADS = 512;
constexpr int NPHASE = 13;

constexpr size_t MiB = 1u << 20, KiB = 1024;
constexpr size_t WS_CTL = 0, CTL_ZERO_BYTES = 64 * KiB;
constexpr size_t WS_RS1 = 1 * MiB, WS_RS2 = WS_RS1 + 128 * KiB;
constexpr size_t WS_TOPE = WS_RS2 + 128 * KiB, WS_TOPG = WS_TOPE + 512 * KiB, WS_SPOS = WS_TOPG + 512 * KiB, WS_SROW = WS_SPOS + 512 * KiB;
constexpr int NROWS_CAP = 131072 + 512;
constexpr size_t WS_RTOK = WS_SROW + 512 * KiB, WS_RGATE = WS_RTOK + 640 * KiB, WS_RRS = WS_RGATE + 640 * KiB;
constexpr size_t WS_LAM = WS_RRS + 640 * KiB;
constexpr size_t WS_TRASH = WS_LAM + 64 * KiB;
constexpr size_t WS_BG = WS_TRASH + 128 * KiB, WS_BU = WS_BG + 128 * KiB, WS_BD = WS_BU + 128 * KiB, WS_BGLU = WS_BD + 128 * KiB;
constexpr size_t WS_G2S = WS_BGLU + 4 * KiB;
constexpr size_t WS_WRIMG = WS_G2S + 8 * KiB;
static_assert(WS_WRIMG + 132096 <= 8 * MiB, "tables");
constexpr size_t WS_WDT = 8 * MiB;
constexpr size_t WS_H1F8 = 40 * MiB;
constexpr size_t WS_H1B = 72 * MiB;
constexpr size_t WS_Y = 136 * MiB;
constexpr size_t WS_W1T = 136 * MiB;
constexpr size_t WS_AS5 = 264 * MiB;
constexpr size_t WS_U = 312 * MiB, WS_V = 344 * MiB;
constexpr size_t WS_WINT = 376 * MiB, WS_W1S = 383 * MiB, WS_MT = 387 * MiB;
constexpr size_t WS_HWS = 393 * MiB;
constexpr size_t WS_SST = 393 * MiB, WS_YAB = 425 * MiB, WS_MRG = 200 * MiB, WS_Z = 489 * MiB;
constexpr size_t WS_RT2 = 376 * MiB, WS_RG2 = 380 * MiB, WS_RR2 = 384 * MiB;
constexpr size_t WS_SMALL = 522 * MiB;
constexpr size_t WS_WGLUT = WS_SMALL, WS_WAT = WS_WGLUT + 512 * KiB, WS_WBT = WS_WAT + 1 * MiB, WS_WOT = WS_WBT + 1 * MiB, WS_WM = WS_WOT + 2 * MiB;
constexpr size_t WS_WINT8 = 527 * MiB;
constexpr size_t WS_END = 529 * MiB;
static_assert(WS_WM + 128 * KiB <= WS_END && WS_YAB + 64 * MiB <= WS_SMALL && WS_MRG + 64 * MiB <= WS_V && WS_Y + 257 * MiB <= WS_HWS && WS_MT + 6 * MiB <= WS_HWS, "ws map");
constexpr int HSPLIT = 65536;
constexpr int CW_BAR = 4096, CW_CNT = 8192;

constexpr int LDS_BYTES = 163840;
constexpr int LDS_X = 131072;
constexpr int LDS_AUX = LDS_X + 16384;
constexpr int LDS_MISC = LDS_BYTES - 256;

#define LDS_WAIT() asm volatile("s_waitcnt lgkmcnt(0)" ::: "memory")
#define VM_WAIT() asm volatile("s_waitcnt vmcnt(0)" ::: "memory")
#define RLX_AGENT __ATOMIC_RELAXED, __HIP_MEMORY_SCOPE_AGENT
__device__ __forceinline__ unsigned cvt_pk_bf16(float lo, float hi) { unsigned r; asm volatile("v_cvt_pk_bf16_f32 %0, %1, %2" : "=v"(r) : "v"(lo), "v"(hi)); return r; }
__device__ __forceinline__ float bflo(unsigned w) { return __builtin_bit_cast(float, w << 16); }
__device__ __forceinline__ float bfhi(unsigned w) { return __builtin_bit_cast(float, w & 0xffff0000u); }
__device__ __forceinline__ f32x4 exp2_v(f32x4 x) { return (f32x4){__builtin_amdgcn_exp2f(x[0]), __builtin_amdgcn_exp2f(x[1]), __builtin_amdgcn_exp2f(x[2]), __builtin_amdgcn_exp2f(x[3])}; }
__device__ __forceinline__ f32x4 rcp_v(f32x4 x) { return (f32x4){__builtin_amdgcn_rcpf(x[0]), __builtin_amdgcn_rcpf(x[1]), __builtin_amdgcn_rcpf(x[2]), __builtin_amdgcn_rcpf(x[3])}; }
__device__ __forceinline__ f32x4 sigmoid_v(f32x4 x) { return rcp_v(exp2_v(x * -1.4426950408889634f) + 1.0f); }
__device__ __forceinline__ f32x4 gelu_v(f32x4 x) { const f32x4 u = x * (x * x * (0.044715f * 2.302208198f) + 2.302208198f); return x * rcp_v(exp2_v(-u) + 1.0f); }
__device__ __forceinline__ float wave_sum(float v) {
#pragma unroll
    for (int o = 1; o < 64; o <<= 1) v += __shfl_xor(v, o);
    return v;
}
__device__ __forceinline__ u32x2 pack8_f8(f32x4 a, f32x4 b) {
    int lo = __builtin_amdgcn_cvt_pk_fp8_f32(a[0], a[1], 0, false); lo = __builtin_amdgcn_cvt_pk_fp8_f32(a[2], a[3], lo, true);
    int hi = __builtin_amdgcn_cvt_pk_fp8_f32(b[0], b[1], 0, false); hi = __builtin_amdgcn_cvt_pk_fp8_f32(b[2], b[3], hi, true);
    return (u32x2){(unsigned)lo, (unsigned)hi}; }
__device__ __forceinline__ u32x4 pack8(f32x4 a, f32x4 b) { u32x4 w; w.x = cvt_pk_bf16(a[0], a[1]); w.y = cvt_pk_bf16(a[2], a[3]); w.z = cvt_pk_bf16(b[0], b[1]); w.w = cvt_pk_bf16(b[2], b[3]); return w; }
__device__ __forceinline__ void unpack8(u32x4 w, f32x4& a, f32x4& b) { a = (f32x4){bflo(w.x), bfhi(w.x), bflo(w.y), bfhi(w.y)}; b = (f32x4){bflo(w.z), bfhi(w.z), bflo(w.w), bfhi(w.w)}; }

#define XB_TMO      128
#define XB_XCNT(j)  (256  + 64 * (j))
#define XB_XSUB(j)  (1280 + 64 * (j))
#define XB_XGEN(j)  (2304 + 64 * (j))
#define XB_TOP      3328
#define XB_TOPGEN   3392
#define XCD_BAR_WORDS 3456
#define XB_SPIN_CAP (1u << 20)
__device__ __forceinline__ unsigned xb_ld(unsigned* p)              { return __hip_atomic_load(p, __ATOMIC_RELAXED, __HIP_MEMORY_SCOPE_AGENT); }
__device__ __forceinline__ unsigned xb_add(unsigned* p, unsigned v) { return __hip_atomic_fetch_add(p, v, __ATOMIC_RELAXED, __HIP_MEMORY_SCOPE_AGENT); }
__device__ __forceinline__ unsigned xb_xcc_id() { return (unsigned)__builtin_amdgcn_s_getreg((3 << 11) | 20) & 0xFu; }
#define XB_SPIN(cond, bar) do { unsigned _sp = 0; while (cond) { __builtin_amdgcn_s_sleep(1); \
    if ((++_sp & 255u) == 0u) { if (xb_ld(&(bar)[XB_TMO])) break; if (_sp > XB_SPIN_CAP) { atomicAdd(&(bar)[XB_TMO], 1u); break; } } } } while (0)
struct XcdBarrier { unsigned* bar; unsigned x; volatile LAS unsigned* st; };
__device__ __forceinline__ XcdBarrier xcd_barrier_post(unsigned* bar, volatile LAS unsigned* st) {
    XcdBarrier b; b.bar = bar; b.x = xb_xcc_id(); b.st = st;
    if (threadIdx.x == 0) st[3] = xb_add(&bar[XB_XCNT(b.x)], 1u);
    return b;
}
__device__ __forceinline__ u32x4 pair16_f8(u32x2 a, u32x2 b) {
    const auto s0 = __builtin_amdgcn_permlane16_swap(a.x, b.x, false, false), s1 = __builtin_amdgcn_permlane16_swap(a.y, b.y, false, false);
    return (u32x4){s0[0], s1[0], s0[1], s1[1]};
}
__device__ __forceinline__ void xcd_barrier_complete(unsigned* bar, unsigned x, unsigned& nloc, unsigned& nx, unsigned& uniform) {
    const unsigned G = gridDim.x * gridDim.y * gridDim.z;
    unsigned sum, cnt, mine, sp = 0u;
    for (;;) {
        sum = 0u; cnt = 0u; mine = 0u;
#pragma unroll
        for (unsigned j = 0; j < 16; ++j) { const unsigned c = xb_ld(&bar[XB_XCNT(j)]); sum += c; cnt += (c > 0u) ? 1u : 0u; mine = (j == x) ? c : mine; }
        if (sum == G) break;
        __builtin_amdgcn_s_sleep(1);
        if ((++sp & 255u) == 0u) { if (xb_ld(&bar[XB_TMO])) break; if (sp > XB_SPIN_CAP) { atomicAdd(&bar[XB_TMO], 1u); break; } }
    }
    nloc = mine > 0u ? mine : 1u; nx = cnt > 0u ? cnt : 1u;
    unsigned u = (sum == G && G == 256u) ? 1u : 0u;
#pragma unroll
    for (unsigned j = 0; j < 16; ++j) { const unsigned c = xb_ld(&bar[XB_XCNT(j)]); if (c != (j < 8u ? G / 8u : 0u)) u = 0u; }
    uniform = u;
}
__device__ __forceinline__ void xcd_barrier(const XcdBarrier& b) {
    asm volatile("s_waitcnt vmcnt(0)" ::: "memory");
    __syncthreads();
    if (threadIdx.x == 0) {
        unsigned* bar = b.bar;
        __builtin_amdgcn_s_waitcnt(0);
        unsigned nloc = b.st[0], nx = b.st[1];
        if (nloc == 0u) { unsigned uni = 0u; xcd_barrier_complete(bar, b.x, nloc, nx, uni); b.st[0] = nloc; b.st[1] = nx; b.st[2] = uni; }
        const unsigned old = xb_add(&bar[XB_XSUB(b.x)], 1u);
        const unsigned gen = old / nloc;
        if (old + 1u == (gen + 1u) * nloc) {
            __builtin_amdgcn_fence(__ATOMIC_RELEASE, "agent");
            asm volatile("s_waitcnt vmcnt(0)" ::: "memory");
            const unsigned og = xb_add(&bar[XB_TOP], 1u);
            const unsigned tg = og / nx;
            if (og + 1u == (tg + 1u) * nx) xb_add(&bar[XB_TOPGEN], 1u);
            else XB_SPIN(xb_ld(&bar[XB_TOPGEN]) == tg, bar);
            xb_add(&bar[XB_XGEN(b.x)], 1u);
            __builtin_amdgcn_fence(__ATOMIC_ACQUIRE, "agent");
            asm volatile("s_waitcnt vmcnt(0)" ::: "memory");
        } else {
            XB_SPIN(xb_ld(&bar[XB_XGEN(b.x)]) == gen, bar);
            __builtin_amdgcn_fence(__ATOMIC_ACQUIRE, "agent");
            asm volatile("s_waitcnt vmcnt(0)" ::: "memory");
        }
    }
    __syncthreads();
}

#define XL_CNT(j) (3456 + 64 * (j))
__device__ __forceinline__ void xcd_local_barrier(unsigned* bar, unsigned x, unsigned target) {
    asm volatile("s_waitcnt vmcnt(0)" ::: "memory");
    __syncthreads();
    if (threadIdx.x == 0) {
        __builtin_amdgcn_s_waitcnt(0);
        (void)xb_add(&bar[XL_CNT(x)], 1u);
        XB_SPIN(xb_ld(&bar[XL_CNT(x)]) < target, bar);
        __builtin_amdgcn_fence(__ATOMIC_ACQUIRE, "agent");
        asm volatile("s_waitcnt vmcnt(0)" ::: "memory");
    }
    __syncthreads();
}

namespace pg8 {
constexpr int BM = 256, BK = 64, HALF = 128, HTB = HALF * BK * 2, STAGE_BYTES = 8 * HTB, NXCD = 8, WGM = 8;
__host__ __device__ __forceinline__ int lds_byte(int r, int c) { const int st = (r >> 4) * 2 + (c >> 5), rr = r & 15, cc = c & 31, ob = rr * 64 + cc * 2; return st * 1024 + (ob ^ (((ob >> 9) & 1) << 5)); }
__host__ __device__ __forceinline__ void stage_rc(int b, int& R, int& C) { const int st = b / 1024, sb = b % 1024, swz = sb ^ (((sb >> 9) & 1) << 5); R = (st >> 1) * 16 + swz / 64; C = (st & 1) * 32 + (swz % 64) / 2; }
__host__ __device__ __forceinline__ int perm32(int rho) { const int n = rho >> 4, i = rho & 15; return 8 * (i >> 2) + 4 * n + (i & 3); }

struct Unit { unsigned a, b; int pm, pn, x0, x1; };
__device__ __forceinline__ void tile_order(int L, int nM, int nN, int& pm, int& pn) {
    const int nwg = nM * nN; int wgid = L; { const int q = nwg / NXCD, r = nwg % NXCD, xcd = wgid % NXCD, off = wgid / NXCD; wgid = (xcd < r ? xcd * (q + 1) : r * (q + 1) + (xcd - r) * q) + off; }
    const int nig = WGM * nN, gid = wgid / nig, fm = gid * WGM, gsz = (nM - fm) < WGM ? (nM - fm) : WGM;
    pm = fm + ((wgid % nig) % gsz); pn = (wgid % nig) / gsz;
}

struct NoHook { static constexpr bool ON = false; __device__ __forceinline__ void operator()(int) const {} };
template <class Epi, class Sched, class Hook = NoHook>
__device__ __forceinline__ void gemm_phase(LAS unsigned char* lds, const void* wsbase, const Sched& S, const Epi& E, const Hook& H = Hook{}) {
    const __amdgpu_buffer_rsrc_t rsrc = __builtin_amdgcn_make_buffer_rsrc((void*)wsbase, 0, 0x7fffffff, 0x00020000);
    constexpr bool GATHER = Sched::GATHER, F8 = Sched::F8;
    int tid_ = threadIdx.x; asm volatile("" : "+v"(tid_));
    const int tid = tid_, wid = __builtin_amdgcn_readfirstlane(tid >> 6), lane = tid & 63, wr = wid >> 2, wc = wid & 3, fr = lane & 15, fq = lane >> 4;
    const int nt = S.nt; const unsigned K2 = S.K2, hstepB = 128u * K2, hstepA = S.hstepA;
    unsigned voffA[2], voffB[2];
#pragma unroll
    for (int i = 0; i < 2; ++i) { int R, C; stage_rc(tid * 16 + i * 8192, R, C); const int Rb = (R & ~31) + perm32(R & 31);
        voffA[i] = (unsigned)R * S.lda2 + (unsigned)C * 2u; voffB[i] = (unsigned)Rb * K2 + (unsigned)C * 2u; }
    const unsigned ldsw = (unsigned)wid * 1024u;
    const int aoff = lds_byte(wr * 64 + fr, fq * 8), boff = lds_byte(wc * 32 + fr, fq * 8);
#define PG8_SA(b, h) (((b) * 2 + (h)) * HTB)
#define PG8_SB(b, h) ((4 + (b) * 2 + (h)) * HTB)
#define PG8_GLDS(vo_, so_, lo) __builtin_amdgcn_raw_ptr_buffer_load_lds(rsrc, (LAS void*)(lds + (lo)), 16, (int)(vo_), (int)(so_), 0, 0)
#define PG8_STAGE_B(bufoff, gbase) do { _Pragma("unroll") for (int _i = 0; _i < 2; ++_i) PG8_GLDS(voffB[_i], (gbase), (bufoff) + ldsw + _i * 8192); } while (0)
#define PG8_STAGE_A(bufoff, gbase, h, VO) do { _Pragma("unroll") for (int _i = 0; _i < 2; ++_i) { \
        if constexpr (GATHER) PG8_GLDS(VO[h][_i], (gbase), (bufoff) + ldsw + _i * 8192); \
        else PG8_GLDS(voffA[_i], (gbase) + (h) * hstepA, (bufoff) + ldsw + _i * 8192); } } while (0)
#define PG8_LDA8(dst, b, h) do { _Pragma("unroll") for (int m = 0; m < 4; ++m) { const i32x4 lo_ = *(const LAS i32x4*)(lds + PG8_SA(b, h) + aoff + m * 2048), hi_ = *(const LAS i32x4*)(lds + PG8_SA(b, h) + aoff + m * 2048 + 1024); dst[m] = __builtin_shufflevector(lo_, hi_, 0, 1, 2, 3, 4, 5, 6, 7); } } while (0)
#define PG8_LDB8(dst, b, h) do { _Pragma("unroll") for (int n = 0; n < 2; ++n) { const i32x4 lo_ = *(const LAS i32x4*)(lds + PG8_SB(b, h) + boff + n * 2048), hi_ = *(const LAS i32x4*)(lds + PG8_SB(b, h) + boff + n * 2048 + 1024); dst[n] = __builtin_shufflevector(lo_, hi_, 0, 1, 2, 3, 4, 5, 6, 7); } } while (0)
#define PG8_LDA_(dst, dst8, b, h) do { if constexpr (F8) PG8_LDA8(dst8, b, h); else PG8_LDA(dst, b, h); } while (0)
#define PG8_LDB_(dst, dst8, b, h) do { if constexpr (F8) PG8_LDB8(dst8, b, h); else PG8_LDB(dst, b, h); } while (0)
#define PG8_LDA(dst, b, h) do { _Pragma("unroll") for (int m = 0; m < 4; ++m) _Pragma("unroll") for (int k = 0; k < 2; ++k) dst[m][k] = *(const LAS bf16x8*)(lds + PG8_SA(b, h) + aoff + m * 2048 + k * 1024); } while (0)
#define PG8_LDB(dst, b, h) do { _Pragma("unroll") for (int n = 0; n < 2; ++n) _Pragma("unroll") for (int k = 0; k < 2; ++k) dst[n][k] = *(const LAS bf16x8*)(lds + PG8_SB(b, h) + boff + n * 2048 + k * 1024); } while (0)
#define PG8_MMA(ai, bj, At, Bt) do { __builtin_amdgcn_s_setprio(1); _Pragma("unroll") for (int m = 0; m < 4; ++m) _Pragma("unroll") for (int n = 0; n < 2; ++n) { \
        if constexpr (F8) asm volatile("s_nop 1\n\tv_mfma_scale_f32_16x16x128_f8f6f4 %0, %1, %2, %0, %3, %3 op_sel_hi:[0,0,0]" : "+v"(acc[ai][bj][m][n]) : "v"(Bt##8[n]), "v"(At##8[m]), "v"(f8scale));   \
        else { _Pragma("unroll") for (int k = 0; k < 2; ++k) asm volatile("s_nop 1\n\tv_mfma_f32_16x16x32_bf16 %0, %1, %2, %0" : "+v"(acc[ai][bj][m][n]) : "v"(Bt[n][k]), "v"(At[m][k])); } }   \
        __builtin_amdgcn_s_setprio(0); } while (0)
#define PG8_WAIT_V(n) asm volatile("s_waitcnt vmcnt(" #n ")" ::: "memory")
#define PG8_WAIT_L(n) asm volatile("s_waitcnt lgkmcnt(" #n ")" ::: "memory")
#define PG8_WAIT_VR(tt) asm volatile("s_cmp_eq_u32 %0, 0\n\ts_cbranch_scc0 .Lwv8_%=\n\ts_waitcnt vmcnt(%1)\n\ts_branch .Lwvd_%=\n.Lwv8_%=:\n\ts_waitcnt vmcnt(8)\n.Lwvd_%=:" :: "s"(tt), "i"((8 + Epi::NST) > 63 ? 63 : (8 + Epi::NST)) : "memory", "scc")
#define PG8_BAR __builtin_amdgcn_s_barrier()
#define PG8_SCHED __builtin_amdgcn_sched_barrier(0)
    Unit cur, nxt; int ui = 0;
    if (!S.next(0, cur)) return;
    unsigned cvo[2][2];
    if constexpr (GATHER) S.aoffs(cur, cvo); else { cvo[0][0] = cvo[0][1] = cvo[1][0] = cvo[1][1] = 0u; }
    f32x4 acc[2][2][4][2];
#pragma unroll
    for (int a = 0; a < 2; ++a)
#pragma unroll
        for (int b = 0; b < 2; ++b)
#pragma unroll
            for (int m = 0; m < 4; ++m)
#pragma unroll
                for (int n = 0; n < 2; ++n) acc[a][b][m][n] = (f32x4){0.f, 0.f, 0.f, 0.f};
    const int f8scale = 0x7f7f7f7f;
    bf16x8 At[4][2], B0[2][2], B1[2][2]; i32x8 At8[4], B08[2], B18[2];
    unsigned cA = cur.a, cB = cur.b;
    const bool skew_ok = !Epi::MID && (nt & (nt - 1)) == 0;
    const unsigned km = skew_ok ? (unsigned)(nt - 1) : 0xffffffffu;
#define PG8_SK(un) (skew_ok ? ((((unsigned)(un).pm >> Sched::SKSH) * 5u) & km) : 0u)
#define PG8_KOF(tt, sk_) ((((unsigned)(tt) + (sk_)) & km) * 128u)
    unsigned sk = PG8_SK(cur);
    PG8_STAGE_B(PG8_SB(0, 0), cB + PG8_KOF(0, sk)); PG8_STAGE_B(PG8_SB(0, 1), cB + hstepB + PG8_KOF(0, sk)); PG8_STAGE_A(PG8_SA(0, 0), cA + PG8_KOF(0, sk), 0, cvo); PG8_STAGE_A(PG8_SA(0, 1), cA + PG8_KOF(0, sk), 1, cvo);
    PG8_STAGE_B(PG8_SB(1, 0), cB + PG8_KOF(1, sk)); PG8_STAGE_B(PG8_SB(1, 1), cB + hstepB + PG8_KOF(1, sk));
    if (wr == 1) PG8_BAR;
    PG8_WAIT_V(0); PG8_BAR; PG8_BAR;
    for (;;) {
        const bool has_next = S.next(ui + 1, nxt);
        const unsigned nA = has_next ? nxt.a : cA, nB = has_next ? nxt.b : cB; const unsigned skn = has_next ? PG8_SK(nxt) : sk;
        for (int t = 0; t < nt; t += 2) {
            const bool last = (t == nt - 2);
            if constexpr (Epi::MID) { if (t == Epi::TMID) { asm volatile("s_nop 15\n\ts_nop 15" ::: "memory"); E.mid(acc, cur, wr, wc, fr, fq); PG8_SCHED; } }
            const unsigned a1 = cA + PG8_KOF(t + 1, sk);
            const unsigned a2 = last ? nA + PG8_KOF(0, skn) : cA + PG8_KOF(t + 2, sk), b2 = last ? nB + PG8_KOF(0, skn) : cB + PG8_KOF(t + 2, sk);
            const unsigned b3 = last ? nB + PG8_KOF(1, skn) : cB + PG8_KOF(t + 3, sk);
            PG8_LDB_(B0, B08, 0, 0); PG8_LDB_(B1, B18, 0, 1); PG8_SCHED; PG8_LDA_(At, At8, 0, 0); PG8_STAGE_A(PG8_SA(1, 0), a1, 0, cvo); PG8_STAGE_A(PG8_SA(1, 1), a1, 1, cvo);
            if constexpr (Epi::NAUX > 0) { if (t == 0 && wid < Epi::NAUX) PG8_GLDS(E.auxoff(cur, wid, lane), 0u, LDS_AUX + (ui & 1) * 4096 + wid * 1024); }
            if constexpr (GATHER) { if (t == 0 && wid == 2 && has_next) PG8_GLDS(S.rtkoff(nxt, lane), 0u, LDS_AUX + (ui & 1) * 4096 + 2048); }
            PG8_WAIT_VR(t); PG8_WAIT_L(0); PG8_BAR; PG8_MMA(0, 0, At, B0); PG8_MMA(0, 1, At, B1); PG8_BAR; PG8_SCHED;
            if constexpr (GATHER) { if (last && has_next) S.aoffs_lds(nxt, (const LAS int*)(lds + LDS_AUX + (ui & 1) * 4096 + 2048), cvo); }
            PG8_LDA_(At, At8, 0, 1); PG8_STAGE_B(PG8_SB(0, 0), b2); PG8_STAGE_B(PG8_SB(0, 1), b2 + hstepB);
            PG8_WAIT_V(6); PG8_WAIT_L(0); PG8_BAR; PG8_MMA(1, 0, At, B0); PG8_MMA(1, 1, At, B1); PG8_BAR; PG8_SCHED;
            PG8_LDB_(B0, B08, 1, 0); PG8_LDB_(B1, B18, 1, 1); PG8_SCHED; PG8_LDA_(At, At8, 1, 0); PG8_STAGE_A(PG8_SA(0, 0), a2, 0, cvo); PG8_STAGE_A(PG8_SA(0, 1), a2, 1, cvo);
            PG8_WAIT_V(8); PG8_WAIT_L(0); PG8_BAR; PG8_MMA(0, 0, At, B0); PG8_MMA(0, 1, At, B1); PG8_BAR; PG8_SCHED;
            PG8_LDA_(At, At8, 1, 1); PG8_STAGE_B(PG8_SB(1, 0), b3); PG8_STAGE_B(PG8_SB(1, 1), b3 + hstepB);
            PG8_WAIT_V(6); PG8_WAIT_L(0); PG8_BAR; PG8_MMA(1, 0, At, B0); PG8_MMA(1, 1, At, B1); PG8_BAR; PG8_SCHED;
        }
        if (wr == 0) PG8_BAR;
        asm volatile("s_nop 15\n\ts_nop 15" ::: "memory");
        E(acc, cur, wr, wc, fr, fq, lds + LDS_AUX + (ui & 1) * 4096);
        PG8_SCHED;
        if constexpr (Hook::ON) { H(ui); PG8_SCHED; }
        if (!has_next) break;
#pragma unroll
        for (int a = 0; a < 2; ++a)
#pragma unroll
            for (int b = 0; b < 2; ++b)
#pragma unroll
                for (int m = 0; m < 4; ++m)
#pragma unroll
                    for (int n = 0; n < 2; ++n) acc[a][b][m][n] = (f32x4){0.f, 0.f, 0.f, 0.f};
        cur = nxt; cA = nA; cB = nB; sk = skn; ++ui;
        if (wr == 1) PG8_BAR;
    }
    PG8_WAIT_V(0);
    PG8_BAR;
#undef PG8_SA
#undef PG8_SK
#undef PG8_KOF
#undef PG8_SB
#undef PG8_GLDS
#undef PG8_STAGE_A
#undef PG8_STAGE_B
#undef PG8_LDA
#undef PG8_LDB
#undef PG8_MMA
#undef PG8_LDA8
#undef PG8_LDB8
#undef PG8_LDA_
#undef PG8_LDB_
#undef PG8_WAIT_V
#undef PG8_WAIT_L
#undef PG8_WAIT_VR
#undef PG8_BAR
#undef PG8_SCHED
}

template <bool F8_>
struct DenseSchedT {
    static constexpr bool GATHER = false, F8 = F8_; static constexpr int SKSH = 0;
    unsigned A, Bt; unsigned lda2, K2, hstepA; int nt, nM, nN, nwg, G, c;
    __device__ __forceinline__ void init(size_t A_, size_t Bt_, int M, int N, int K, int lda, int G_, int c_) {
        constexpr unsigned esz = F8_ ? 1u : 2u;
        A = (unsigned)A_; Bt = (unsigned)Bt_; lda2 = (unsigned)lda * esz; K2 = (unsigned)K * esz; hstepA = 128u * lda2; nt = (int)(K2 / 128u); nM = M / 256; nN = N / 256; nwg = nM * nN; G = G_; c = c_; }
    __device__ __forceinline__ bool next(int i, Unit& u) const {
        const long L = (long)i * G + c; if (L >= nwg) return false;
        tile_order((int)L, nM, nN, u.pm, u.pn);
        u.a = A + (unsigned)u.pm * 256u * lda2; u.b = Bt + (unsigned)u.pn * 256u * K2; u.x0 = 0; u.x1 = 0; return true; }
    __device__ __forceinline__ void aoffs(const Unit&, unsigned (&)[2][2]) const {}
};
typedef DenseSchedT<false> DenseSched;
struct S5Sched {
    static constexpr bool GATHER = false, F8 = false; static constexpr int SKSH = 0;
    unsigned A, Bt; unsigned lda2, K2, hstepA; int nt, id;
    __device__ __forceinline__ void init(size_t A_, size_t Bt_, int K, int id_) { A = (unsigned)A_; Bt = (unsigned)Bt_; lda2 = AS5_LD * 2; K2 = (unsigned)K * 2u; hstepA = 128u * lda2; nt = K / 64; id = id_; }
    __device__ __forceinline__ bool next(int i, Unit& u) const {
        if (i > 0 || id >= 256) return false;
        const int g = id >> 3; u.pm = id & 7; u.pn = 0; u.x0 = g; u.x1 = 0;
        u.a = A + ((unsigned)g * 2048u + (unsigned)u.pm * 256u) * lda2; u.b = Bt + (unsigned)g * 256u * K2; return true; }
    __device__ __forceinline__ void aoffs(const Unit&, unsigned (&)[2][2]) const {}
};
struct MoeSched1 {
    static constexpr bool GATHER = true, F8 = true; static constexpr int SKSH = 8;
    unsigned A, Bt; const int* rtk; const LAS int* tt; unsigned lda2, K2, hstepA; int nt, ntiles, G, vc;
    __device__ __forceinline__ bool next(int i, Unit& u) const {
        const int L = i * G + vc; const int tile = L >> 3; if (tile >= ntiles) return false;
        const int w0 = __builtin_amdgcn_readfirstlane(tt[2 * tile]), row0 = __builtin_amdgcn_readfirstlane(tt[2 * tile + 1]);
        const int e = w0 & 255; u.pm = e * T + (row0 - __builtin_amdgcn_readfirstlane(tt[1432 + e])); u.pn = L & 7; u.x0 = row0; u.x1 = w0;
        u.a = A; u.b = Bt + ((unsigned)e * 2048u + (unsigned)u.pn * 256u) * K2; return true; }
    __device__ __forceinline__ unsigned rtkoff(const Unit& u, int lane) const { return (unsigned)WS_RT2 + (unsigned)u.pm * 4u + (unsigned)lane * 16u; }
    __device__ __forceinline__ void aoffs_lds(const Unit& u, const LAS int* tl, unsigned (&vo)[2][2]) const {
        const int nrows = u.x1 >> 8; int Rr[2], Cc[2];
        { int t_ = threadIdx.x; asm volatile("" : "+v"(t_));
#pragma unroll
        for (int i = 0; i < 2; ++i) stage_rc(t_ * 16 + i * 8192, Rr[i], Cc[i]); }
#pragma unroll
        for (int h = 0; h < 2; ++h)
#pragma unroll
            for (int i = 0; i < 2; ++i) { const int rl = h * 128 + Rr[i]; const int tok = rl < nrows ? tl[rl] : 0; vo[h][i] = (unsigned)tok * 1024u + (unsigned)Cc[i] * 2u; }
    }
    __device__ __forceinline__ void aoffs(const Unit& u, unsigned (&vo)[2][2]) const {
        const int nrows = u.x1 >> 8; int Rr[2], Cc[2];
        { int t_ = threadIdx.x; asm volatile("" : "+v"(t_));
#pragma unroll
        for (int i = 0; i < 2; ++i) stage_rc(t_ * 16 + i * 8192, Rr[i], Cc[i]); }
#pragma unroll
        for (int h = 0; h < 2; ++h)
#pragma unroll
            for (int i = 0; i < 2; ++i) { const int rl = h * 128 + Rr[i]; const int tok = rl < nrows ? rtk[u.pm + rl] : 0; vo[h][i] = (unsigned)tok * 1024u + (unsigned)Cc[i] * 2u; }
    }
};
struct MoeSched2 {
    static constexpr bool GATHER = false, F8 = true; static constexpr int SKSH = 8;
    unsigned Ahi, Bt; const LAS int* tt; unsigned lda2, K2, hstepA; int nt, ntiles, G, vc;
    __device__ __forceinline__ bool next(int i, Unit& u) const {
        const int L = i * G + vc; const int tile = L >> 2; if (tile >= ntiles) return false;
        const int w0 = __builtin_amdgcn_readfirstlane(tt[2 * tile]), row0 = __builtin_amdgcn_readfirstlane(tt[2 * tile + 1]);
        const int e = w0 & 255; u.pm = e * T + (row0 - __builtin_amdgcn_readfirstlane(tt[1432 + e])); u.pn = L & 3; u.x0 = row0; u.x1 = w0;
        u.a = Ahi + (unsigned)row0 * 1024u; u.b = Bt + ((unsigned)e * 1024u + (unsigned)u.pn * 256u) * K2; return true; }
    __device__ __forceinline__ void aoffs(const Unit&, unsigned (&)[2][2]) const {}
};

#define EPI_ARGS const f32x4 (&acc)[2][2][4][2], const Unit& u, int wr, int wc, int fr_in, int fq_in, const LAS unsigned char* aux
#define EPI_LAUNDER int fr = fr_in, fq = fq_in; asm volatile("" : "+v"(fr), "+v"(fq));
#define INP_F8_GROUPS {0, 2}
#define INP_BF_GROUPS {1}
#define MOE_KSG 2.455467f
#define INP_NF8 2
#define INP_NBF 1
struct EpiInProj {
    static constexpr bool MID = false; static constexpr int TMID = 0; static constexpr int NAUX = 1;
    static constexpr int NST = 16;
    __device__ __forceinline__ unsigned auxoff(const Unit& u, int, int lane) const { return (unsigned)WS_RS1 + (unsigned)(u.pm * 256) * 4u + (unsigned)lane * 16u; }
    bf16_t *AS5, *U, *V; int pmap; float wsc;
    __device__ __forceinline__ void operator()(EPI_ARGS) const {
        EPI_LAUNDER
        const int row0 = u.pm * 256 + wr * 64 + fr, colw = wc * 32 + 8 * fq, pn = (pmap >> (4 * u.pn)) & 15;
        const int mode = pn < 2 ? 0 : 1;
#pragma unroll
        for (int ai = 0; ai < 2; ++ai)
#pragma unroll
            for (int m = 0; m < 4; ++m) { const int row = row0 + ai * 128 + m * 16; const float rs = ((const LAS float*)aux)[ai * 128 + wr * 64 + m * 16 + fr] * wsc;
#pragma unroll
                for (int bj = 0; bj < 2; ++bj) { const int c = pn * 256 + bj * 128 + colw; f32x4 v0 = acc[ai][bj][m][0] * rs, v1 = acc[ai][bj][m][1] * rs; bf16_t* dst;
                    if (mode == 0) { dst = AS5 + ((size_t)((c >> 4) * 2048 + (row >> 4)) * AS5_LD + (row & 15) * 16 + (c & 15)); }
                    else {
                        v0 = gelu_v(v0); v1 = gelu_v(v1);
                        dst = (pn < 4 ? U + (size_t)row * 512 + (c - 512) : V + (size_t)row * 512 + (c - 1024)); }
                    *(u32x4*)dst = pack8(v0, v1); } }
    }
};
struct EpiGates {
    static constexpr bool MID = false; static constexpr int TMID = 0; static constexpr int NAUX = 1;
    static constexpr int NST = 16;
    __device__ __forceinline__ unsigned auxoff(const Unit& u, int, int lane) const { return (unsigned)WS_RS1 + (unsigned)(u.pm * 256) * 4u + (unsigned)lane * 16u; }
    bf16_t *GA, *GB;
    __device__ __forceinline__ void operator()(EPI_ARGS) const {
        EPI_LAUNDER
        const int row0 = u.pm * 256 + wr * 64 + fr, c = u.pn * 128 + wc * 32 + 8 * fq;
#pragma unroll
        for (int ai = 0; ai < 2; ++ai)
#pragma unroll
            for (int m = 0; m < 4; ++m) { const int row = row0 + ai * 128 + m * 16; const float rs = ((const LAS float*)aux)[ai * 128 + wr * 64 + m * 16 + fr] * 0.03125f;
                f32x4 a0 = acc[ai][0][m][0] * rs, a1 = acc[ai][0][m][1] * rs, b0 = acc[ai][1][m][0] * rs, b1 = acc[ai][1][m][1] * rs;
                { const f32x4 ea = exp2_v(a0 * -1.4426950408889634f) + 1.0f, eb = exp2_v(b0 * -1.4426950408889634f) + 1.0f, ec = exp2_v(a1 * -1.4426950408889634f) + 1.0f, ed = exp2_v(b1 * -1.4426950408889634f) + 1.0f;
                  b0 = rcp_v(eb); a0 = eb * rcp_v(ea); b1 = rcp_v(ed); a1 = ed * rcp_v(ec); }
                const size_t off = (size_t)row * 1024 + c; *(u32x4*)(GA + off) = pack8(a0, a1); *(u32x4*)(GB + off) = pack8(b0, b1); }
    }
};
struct EpiS5End {
    static constexpr bool MID = false; static constexpr int TMID = 0; static constexpr int NAUX = 0;
    static constexpr int NST = 16;
    float* SST;
    __device__ __forceinline__ void operator()(EPI_ARGS) const {
        EPI_LAUNDER
        const int row0 = u.pm * 256 + wr * 64 + fr, colw = wc * 32 + 8 * fq, g = u.x0;
#pragma unroll
        for (int ai = 0; ai < 2; ++ai)
#pragma unroll
            for (int m = 0; m < 4; ++m) { const int row = row0 + ai * 128 + m * 16; float* dst = SST + (size_t)row * 4096 + g * 128 + colw;
                *(f32x4*)dst = acc[ai][0][m][0]; *(f32x4*)(dst + 4) = acc[ai][0][m][1]; }
    }
};
struct EpiS5Out {
    static constexpr bool MID = false; static constexpr int TMID = 0; static constexpr int NAUX = 0;
    static constexpr int NST = 16;
    bf16_t* Z;
    __device__ __forceinline__ void operator()(EPI_ARGS) const {
        EPI_LAUNDER
        const int row0 = u.pm * 256 + wr * 64 + fr, colw = wc * 32 + 8 * fq, g = u.x0;
#pragma unroll
        for (int ai = 0; ai < 2; ++ai)
#pragma unroll
            for (int m = 0; m < 4; ++m) { const int row = row0 + ai * 128 + m * 16;
#pragma unroll
                for (int bj = 0; bj < 2; ++bj) { const int c = bj * 128 + colw; f32x4 v0 = acc[ai][bj][m][0], v1 = acc[ai][bj][m][1];
                    v0 = gelu_v(v0); v1 = gelu_v(v1);
                    *(u32x4*)(Z + ((size_t)row * 16 + (c >> 4)) * 512 + g * 16 + (c & 15)) = pack8(v0, v1); } }
    }
};
struct EpiGlu {
    static constexpr bool MID = false; static constexpr int TMID = 0; static constexpr int NAUX = 1;
    static constexpr int NST = 16;
    __device__ __forceinline__ unsigned auxoff(const Unit& u, int, int lane) const { return (unsigned)WS_BGLU + (unsigned)(u.pn * 256) * 4u + (unsigned)lane * 16u; }
    const bf16_t* Z; const float* bglu; bf16_t* YA;
    __device__ __forceinline__ void operator()(EPI_ARGS) const {
        EPI_LAUNDER
        const int row0 = u.pm * 256 + wr * 64 + fr, colw = wc * 32 + 8 * fq;
        f32x4 bb[2][2];
#pragma unroll
        for (int bj = 0; bj < 2; ++bj) { bb[bj][0] = *(const LAS f32x4*)(aux + (bj * 128 + colw) * 4); bb[bj][1] = *(const LAS f32x4*)(aux + (bj * 128 + colw) * 4 + 16); }
#pragma unroll
        for (int ai = 0; ai < 2; ++ai) { u32x4 rr[4][2];
#pragma unroll
            for (int m = 0; m < 4; ++m)
#pragma unroll
                for (int bj = 0; bj < 2; ++bj) rr[m][bj] = *(const u32x4*)(Z + (size_t)(row0 + ai * 128 + m * 16) * 512 + u.pn * 256 + bj * 128 + colw);
#pragma unroll
            for (int m = 0; m < 4; ++m)
#pragma unroll
                for (int bj = 0; bj < 2; ++bj) { const int row = row0 + ai * 128 + m * 16, c = u.pn * 256 + bj * 128 + colw;
                    f32x4 z0, z1; unpack8(rr[m][bj], z0, z1); f32x4 v0 = acc[ai][bj][m][0] + bb[bj][0], v1 = acc[ai][bj][m][1] + bb[bj][1];
                    v0 = z0 * sigmoid_v(v0); v1 = z1 * sigmoid_v(v1);
                    *(u32x4*)(YA + (size_t)row * 1024 + c) = pack8(v0, v1); }
            asm volatile("" ::: "memory"); }
    }
};
struct EpiMerge {
    static constexpr bool MID = true; static constexpr int TMID = 8; static constexpr int NAUX = 0;
    static constexpr int NST = 16;
    const bf16_t *GA, *GB; bf16_t* MRG;
    __device__ __forceinline__ void mid(f32x4 (&acc)[2][2][4][2], const Unit& u, int wr, int wc, int fr_in, int fq_in) const {
        EPI_LAUNDER
        const int row0 = u.pm * 256 + wr * 64 + fr, colw = wc * 32 + 8 * fq;
#pragma unroll
        for (int ai = 0; ai < 2; ++ai) { u32x4 rr[4][2];
#pragma unroll
            for (int m = 0; m < 4; ++m)
#pragma unroll
                for (int bj = 0; bj < 2; ++bj) rr[m][bj] = *(const u32x4*)(GA + (size_t)(row0 + ai * 128 + m * 16) * 1024 + u.pn * 256 + bj * 128 + colw);
#pragma unroll
            for (int m = 0; m < 4; ++m)
#pragma unroll
                for (int bj = 0; bj < 2; ++bj) { f32x4 a0, a1; unpack8(rr[m][bj], a0, a1); acc[ai][bj][m][0] *= a0; acc[ai][bj][m][1] *= a1; }
            asm volatile("" ::: "memory"); }
    }
    __device__ __forceinline__ void operator()(EPI_ARGS) const {
        EPI_LAUNDER
        const int row0 = u.pm * 256 + wr * 64 + fr, colw = wc * 32 + 8 * fq;
#pragma unroll
        for (int ai = 0; ai < 2; ++ai) { u32x4 rr[4][2];
#pragma unroll
            for (int m = 0; m < 4; ++m)
#pragma unroll
                for (int bj = 0; bj < 2; ++bj) rr[m][bj] = *(const u32x4*)(GB + (size_t)(row0 + ai * 128 + m * 16) * 1024 + u.pn * 256 + bj * 128 + colw);
#pragma unroll
            for (int m = 0; m < 4; ++m)
#pragma unroll
                for (int bj = 0; bj < 2; ++bj) { const size_t off = (size_t)(row0 + ai * 128 + m * 16) * 1024 + u.pn * 256 + bj * 128 + colw;
                    f32x4 b0, b1; unpack8(rr[m][bj], b0, b1); *(u32x4*)(MRG + off) = pack8(acc[ai][bj][m][0] * b0, acc[ai][bj][m][1] * b1); }
            asm volatile("" ::: "memory"); }
    }
};
struct EpiOutProj {
    static constexpr bool MID = false; static constexpr int TMID = 0; static constexpr int NAUX = 0;
    static constexpr int NST = 24;
    bf16_t* H1b; unsigned char* H1f8;
    __device__ __forceinline__ void operator()(EPI_ARGS) const {
        EPI_LAUNDER
        const int row0 = u.pm * 256 + wr * 64 + fr, colw = wc * 32 + 8 * fq;
#pragma unroll
        for (int ai = 0; ai < 2; ++ai) { u32x4 rr[4][2];
#pragma unroll
            for (int m = 0; m < 4; ++m)
#pragma unroll
                for (int bj = 0; bj < 2; ++bj) rr[m][bj] = *(const u32x4*)(H1b + (size_t)(row0 + ai * 128 + m * 16) * 1024 + u.pn * 256 + bj * 128 + colw);
#pragma unroll
            for (int mp = 0; mp < 2; ++mp)
#pragma unroll
                for (int bj = 0; bj < 2; ++bj) { u32x2 h8[2];
#pragma unroll
                    for (int q = 0; q < 2; ++q) { const int m = 2 * mp + q; const size_t off = (size_t)(row0 + ai * 128 + m * 16) * 1024 + u.pn * 256 + bj * 128 + colw;
                        f32x4 x0, x1; unpack8(rr[m][bj], x0, x1); const f32x4 v0 = acc[ai][bj][m][0] + x0, v1 = acc[ai][bj][m][1] + x1;
                        *(u32x4*)(H1b + off) = pack8(v0, v1); h8[q] = pack8_f8(v0, v1); }
                    *(u32x4*)(H1f8 + (size_t)(row0 + ai * 128 + mp * 32 + 16 * (fq & 1)) * 1024 + u.pn * 256 + bj * 128 + wc * 32 + 16 * (fq >> 1)) = pair16_f8(h8[0], h8[1]); }
            asm volatile("" ::: "memory"); }
    }
};
struct EpiMoe1 {
    static constexpr bool MID = false; static constexpr int TMID = 0; static constexpr int NAUX = 2;
    static constexpr int NST = 4;
    __device__ __forceinline__ unsigned auxoff(const Unit& u, int piece, int lane) const { const int e = u.x1 & 255;
        return piece == 0 ? (unsigned)WS_RR2 + (unsigned)u.pm * 4u + (unsigned)lane * 16u : (lane < 32 ? (unsigned)WS_BG : (unsigned)WS_BU - 512u) + (unsigned)(e * 1024 + u.pn * 128) * 4u + (unsigned)lane * 16u; }
    const float *rrs, *bgate, *bup; unsigned char *H8, *trash;
    __device__ __forceinline__ void operator()(EPI_ARGS) const {
        EPI_LAUNDER
        const int rl0 = wr * 64 + fr, colw = wc * 32 + 8 * fq, row0 = u.x0, nrows = u.x1 >> 8, e = u.x1 & 255; const int c = u.pn * 128 + wc * 32 + 16 * (fq >> 1);
        const LAS float* ab = (const LAS float*)(aux + 1024); const f32x4 bg0 = *(const LAS f32x4*)(ab + colw), bg1 = *(const LAS f32x4*)(ab + colw + 4), bu0 = *(const LAS f32x4*)(ab + 128 + colw), bu1 = *(const LAS f32x4*)(ab + 128 + colw + 4);
        unsigned char* Hb = H8 + (size_t)row0 * 1024;
#pragma unroll
        for (int ai = 0; ai < 2; ++ai)
#pragma unroll
            for (int mp = 0; mp < 2; ++mp) { u32x2 hp[2];
#pragma unroll
                for (int q = 0; q < 2; ++q) { const int m = 2 * mp + q; const float rs = ((const LAS float*)aux)[rl0 + ai * 128 + m * 16] * 0.03125f;
                    f32x4 g0 = acc[ai][0][m][0] * rs + bg0, g1 = acc[ai][0][m][1] * rs + bg1, l0 = acc[ai][1][m][0] * rs + bu0, l1 = acc[ai][1][m][1] * rs + bu1;
                    { const f32x4 gmax = (f32x4){7.0f * MOE_KSG, 7.0f * MOE_KSG, 7.0f * MOE_KSG, 7.0f * MOE_KSG}, lmin = (f32x4){-6.0f / MOE_KSG, -6.0f / MOE_KSG, -6.0f / MOE_KSG, -6.0f / MOE_KSG}, lmax = (f32x4){8.0f / MOE_KSG, 8.0f / MOE_KSG, 8.0f / MOE_KSG, 8.0f / MOE_KSG};
                      g0 = __builtin_elementwise_min(g0, gmax); g1 = __builtin_elementwise_min(g1, gmax);
                      l0 = __builtin_elementwise_min(__builtin_elementwise_max(l0, lmin), lmax); l1 = __builtin_elementwise_min(__builtin_elementwise_max(l1, lmin), lmax);
                      g0 = g0 * rcp_v(exp2_v(-g0) + 1.0f) * l0; g1 = g1 * rcp_v(exp2_v(-g1) + 1.0f) * l1; }
                    hp[q] = pack8_f8(g0, g1); }
                const int rl = rl0 + ai * 128 + mp * 32 + 16 * (fq & 1); const bool ok = rl < nrows;
                unsigned char* dst = ok ? Hb + (size_t)rl * 1024 + c : trash + (size_t)(rl & 63) * 1024 + c;
                *(u32x4*)dst = pair16_f8(hp[0], hp[1]); }
    }
};
struct EpiMoe2 {
    static constexpr bool MID = false; static constexpr int TMID = 0; static constexpr int NAUX = 2;
    static constexpr int NST = 8;
    __device__ __forceinline__ unsigned auxoff(const Unit& u, int piece, int lane) const { const int e = u.x1 & 255;
        return piece == 0 ? (unsigned)WS_RG2 + (unsigned)u.pm * 4u + (unsigned)lane * 16u : (unsigned)WS_BD + (unsigned)(e * 1024 + u.pn * 256) * 4u + (unsigned)lane * 16u; }
    const float *rgate, *bdown; unsigned char *Y, *trash;
    __device__ __forceinline__ void operator()(EPI_ARGS) const {
        EPI_LAUNDER
        const int rl0 = wr * 64 + fr, colw = wc * 32 + 8 * fq, row0 = u.x0, nrows = u.x1 >> 8, e = u.x1 & 255;
#pragma unroll
        for (int bj = 0; bj < 2; ++bj) { const int c = u.pn * 256 + bj * 128 + wc * 32 + 16 * (fq >> 1); const f32x4 b0 = *(const LAS f32x4*)(aux + 1024 + (bj * 128 + colw) * 4) * 32.0f, b1 = *(const LAS f32x4*)(aux + 1024 + (bj * 128 + colw) * 4 + 16) * 32.0f;
#pragma unroll
            for (int ai = 0; ai < 2; ++ai)
#pragma unroll
                for (int mp = 0; mp < 2; ++mp) { const int rla = rl0 + ai * 128 + mp * 32; const float ga = ((const LAS float*)aux)[rla] * 0.5f, gb = ((const LAS float*)aux)[rla + 16] * 0.5f;
                    const u32x4 o = pair16_f8(pack8_f8((acc[ai][bj][2 * mp][0] + b0) * ga, (acc[ai][bj][2 * mp][1] + b1) * ga), pack8_f8((acc[ai][bj][2 * mp + 1][0] + b0) * gb, (acc[ai][bj][2 * mp + 1][1] + b1) * gb));
                    const int rl = rla + 16 * (fq & 1); const bool ok = rl < nrows;
                    unsigned char* dst = ok ? Y + (size_t)(row0 + rl) * 1024 + c : trash + (size_t)(rl & 63) * 1024 + c;
                    *(u32x4*)dst = o; } }
    }
};
}

struct TrJob { const float* W; const float* ks; bf16_t* WT; int ldw, ldt, k0, n0, add, f8; };
__device__ __forceinline__ void transpose_load(const TrJob& j, int lane, f32x4 (&v)[8]) {
    const int kg = lane >> 3, ng = lane & 7; const float* p = j.W + (size_t)(j.k0 + 8 * kg) * j.ldw + j.n0 + 4 * ng;
#pragma unroll
    for (int e = 0; e < 8; ++e) v[e] = __builtin_nontemporal_load((const f32x4*)(p + (size_t)e * j.ldw));
}
__device__ __forceinline__ void transpose_store(const TrJob& j, int lane, f32x4 (&v)[8]) {
    const int kg = lane >> 3, ng = lane & 7;
    if (j.ks) { const f32x4 s0 = *(const f32x4*)(j.ks + j.k0 + 8 * kg), s1 = *(const f32x4*)(j.ks + j.k0 + 8 * kg + 4);
#pragma unroll
        for (int e = 0; e < 4; ++e) { v[e] *= s0[e]; v[4 + e] *= s1[e]; } }
#pragma unroll
    for (int c = 0; c < 4; ++c) { const int n = j.n0 + 4 * ng + c; const int row = j.add < 0 ? n : ((n >> 7) * 256 + (n & 127) + j.add);
        if (j.f8) { *(u32x2*)((unsigned char*)j.WT + (size_t)row * j.ldt + j.k0 + 8 * kg) = pack8_f8((f32x4){v[0][c], v[1][c], v[2][c], v[3][c]} * 32.0f, (f32x4){v[4][c], v[5][c], v[6][c], v[7][c]} * 32.0f); }
        else { u32x4 o; o.x = cvt_pk_bf16(v[0][c], v[1][c]); o.y = cvt_pk_bf16(v[2][c], v[3][c]); o.z = cvt_pk_bf16(v[4][c], v[5][c]); o.w = cvt_pk_bf16(v[6][c], v[7][c]);
            *(u32x4*)(j.WT + (size_t)row * j.ldt + j.k0 + 8 * kg) = o; } }
}

__device__ __forceinline__ void transpose8_load(const TrJob& j, int lane, f32x4 (&v)[16]) {
    const int kg = lane >> 3, ng = lane & 7; const float* p = j.W + (size_t)(j.k0 + 16 * kg) * j.ldw + j.n0 + 4 * ng;
#pragma unroll
    for (int e = 0; e < 16; ++e) v[e] = __builtin_nontemporal_load((const f32x4*)(p + (size_t)e * j.ldw));
}
__device__ __forceinline__ void transpose8_store(const TrJob& j, int lane, f32x4 (&v)[16]) {
    const int kg = lane >> 3, ng = lane & 7;
    if (j.ks) {
#pragma unroll
        for (int q = 0; q < 4; ++q) { const f32x4 s = *(const f32x4*)(j.ks + j.k0 + 16 * kg + 4 * q);
#pragma unroll
            for (int e = 0; e < 4; ++e) v[4 * q + e] *= s[e]; } }
#pragma unroll
    for (int c = 0; c < 4; ++c) { const int n = j.n0 + 4 * ng + c; const int row = j.add < 0 ? n : ((n >> 7) * 256 + (n & 127) + j.add);
        const u32x2 lo = pack8_f8((f32x4){v[0][c], v[1][c], v[2][c], v[3][c]} * 32.0f, (f32x4){v[4][c], v[5][c], v[6][c], v[7][c]} * 32.0f);
        const u32x2 hi = pack8_f8((f32x4){v[8][c], v[9][c], v[10][c], v[11][c]} * 32.0f, (f32x4){v[12][c], v[13][c], v[14][c], v[15][c]} * 32.0f);
        *(u32x4*)((unsigned char*)j.WT + (size_t)row * j.ldt + j.k0 + 16 * kg) = (u32x4){lo.x, lo.y, hi.x, hi.y}; }
}

__device__ __forceinline__ void transpose8_store_sc(const TrJob& j, int lane, f32x4 (&v)[16], const f32x4 (&sc)[4]) {
    const int kg = lane >> 3, ng = lane & 7;
#pragma unroll
    for (int c = 0; c < 4; ++c) { const int n = j.n0 + 4 * ng + c; const int row = j.add < 0 ? n : ((n >> 7) * 256 + (n & 127) + j.add);
        const u32x2 lo = pack8_f8((f32x4){v[0][c], v[1][c], v[2][c], v[3][c]} * sc[0], (f32x4){v[4][c], v[5][c], v[6][c], v[7][c]} * sc[1]);
        const u32x2 hi = pack8_f8((f32x4){v[8][c], v[9][c], v[10][c], v[11][c]} * sc[2], (f32x4){v[12][c], v[13][c], v[14][c], v[15][c]} * sc[3]);
        *(u32x4*)((unsigned char*)j.WT + (size_t)row * j.ldt + j.k0 + 16 * kg) = (u32x4){lo.x, lo.y, hi.x, hi.y}; }
}

struct Args { const float* in[30]; float* out; unsigned char* ws; int ph_lo, ph_hi; };
__device__ __forceinline__ const float* in_ptr_(int byte_off) { const float* p; asm volatile("s_load_dwordx2 %0, %1, %2\n\ts_waitcnt lgkmcnt(0)" : "=s"(p) : "s"(__builtin_amdgcn_kernarg_segment_ptr()), "i"(byte_off)); return p; }
#define INP(k) in_ptr_((k) * 8)


__device__ __forceinline__ void s5_build_group(const Args& args, int g, LAS unsigned char* lds, int tid) {
    const float *lam_re = INP(3), *lam_im = INP(4), *log_dt = INP(5), *b_re = INP(6), *b_im = INP(7), *c_re = INP(8), *c_im = INP(9), *d_skip = INP(10);
    LAS f32x2* pw = (LAS f32x2*)lds;
    LAS f32x2* bb = pw + 17 * 64;
    LAS f32x2* Cg = bb + 64 * 16;
    LAS float* Kt = (LAS float*)(Cg + 16 * 64);
    bf16_t* W1s = (bf16_t*)(args.ws + WS_W1S) + (size_t)g * 256 * 256;
    bf16_t* MT = (bf16_t*)(args.ws + WS_MT) + (size_t)g * 256 * 384;
    f32x2* lamtab = (f32x2*)(args.ws + WS_LAM);
    { const float dt = expf(log_dt[g]);
      for (int i = tid; i < 19 * 64; i += NTHREADS) { const int m = i >> 6, n = i & 63; const float lr = lam_re[g * 64 + n], li = lam_im[g * 64 + n];
          const float mf = m <= 16 ? (float)m : (m == 17 ? 16.0f : 512.0f); const float mag = expf(lr * dt * mf); float sn, cs; sincosf(li * dt * mf, &sn, &cs);
          if (m <= 16) pw[m * 64 + n] = (f32x2){mag * cs, mag * sn}; else lamtab[(m - 17) * 2048 + g * 64 + n] = (f32x2){mag * cs, mag * sn}; } }
    __syncthreads();
    for (int i = tid; i < 1024; i += NTHREADS) { const int n = i >> 4, q = i & 15; const float lr = lam_re[g * 64 + n], li = lam_im[g * 64 + n];
        const f32x2 lb = pw[64 + n]; const float nr = lb.x - 1.0f, ni = lb.y, den = 1.0f / (lr * lr + li * li);
        const float cr = (nr * lr + ni * li) * den, ci = (ni * lr - nr * li) * den;
        const float br = b_re[(g * 64 + n) * 16 + q], bi = b_im[(g * 64 + n) * 16 + q]; bb[n * 16 + q] = (f32x2){cr * br - ci * bi, cr * bi + ci * br}; }
    for (int i = tid; i < 1024; i += NTHREADS) Cg[i] = (f32x2){c_re[g * 1024 + i], c_im[g * 1024 + i]};
    __syncthreads();
    for (int i = tid; i < 4096; i += NTHREADS) { const int tau = i >> 8, p = (i >> 4) & 15, q = i & 15; float s = 0.f;
        for (int n = 0; n < 64; ++n) { const f32x2 c = Cg[p * 64 + n], w = pw[tau * 64 + n], b = bb[n * 16 + q];
            const float xr = c.x * w.x - c.y * w.y, xi = c.x * w.y + c.y * w.x; s += xr * b.x - xi * b.y; }
        if (tau == 0 && p == q) s += d_skip[g * 16 + p];
        Kt[i] = s; }
    __syncthreads();
    for (int i = tid; i < 256 * 48; i += NTHREADS) { const int row = i / 48, ch = i % 48, t = row >> 4, p = row & 15, k0 = ch * 8; float v[8];
        if (k0 < 256) { const int j = k0 >> 4, q0 = k0 & 15;
#pragma unroll
            for (int e = 0; e < 8; ++e) v[e] = (j <= t) ? Kt[((t - j) * 16 + p) * 16 + q0 + e] : 0.f; }
        else {
#pragma unroll
            for (int e = 0; e < 8; ++e) { const int sidx = k0 - 256 + e, n = sidx & 63; const f32x2 c = Cg[p * 64 + n], w = pw[(t + 1) * 64 + n];
                v[e] = (sidx < 64) ? (c.x * w.x - c.y * w.y) : -(c.x * w.y + c.y * w.x); } }
        u32x4 o; o.x = cvt_pk_bf16(v[0], v[1]); o.y = cvt_pk_bf16(v[2], v[3]); o.z = cvt_pk_bf16(v[4], v[5]); o.w = cvt_pk_bf16(v[6], v[7]);
        *(u32x4*)(MT + (size_t)row * 384 + k0) = o; }
    for (int i = tid; i < 256 * 32; i += NTHREADS) { const int row = i >> 5, k0 = (i & 31) * 8, j = k0 >> 4, q0 = k0 & 15; float v[8];
#pragma unroll
        for (int e = 0; e < 8; ++e) { if (row < 128) { const int n = row & 63; const f32x2 w = pw[(15 - j) * 64 + n], b = bb[n * 16 + q0 + e];
                v[e] = (row < 64) ? (w.x * b.x - w.y * b.y) : (w.x * b.y + w.y * b.x); } else v[e] = 0.f; }
        u32x4 o; o.x = cvt_pk_bf16(v[0], v[1]); o.y = cvt_pk_bf16(v[2], v[3]); o.z = cvt_pk_bf16(v[4], v[5]); o.w = cvt_pk_bf16(v[6], v[7]);
        *(u32x4*)(W1s + (size_t)row * 256 + k0) = o; }
    __syncthreads();
}

__device__ __forceinline__ int moe_build_tiles(gu32* counts, LAS int* tt, int tid) {
    LAS int* cnt = tt + 1400; LAS int* st = cnt + 32; LAS int* tb = st + 33;
    if (tid < 32) cnt[tid] = (int)__hip_atomic_load(counts + tid, RLX_AGENT);
    __syncthreads();
    if (tid == 0) { int s = 0, b = 0;
        for (int e = 0; e < 32; ++e) { const int n = cnt[e]; if (s < HSPLIT && s + n > HSPLIT) s += (HSPLIT - s) & 255; st[e] = s; tb[e] = b; s += n; b += (n + 255) >> 8; }
        st[32] = s; tb[32] = b; }
    __syncthreads();
    if (tid < 32) { const int n = cnt[tid], s = st[tid], b = tb[tid]; const int k = (n + 255) >> 8;
        for (int m = 0; m < k; ++m) { const int nr = (n - m * 256) < 256 ? (n - m * 256) : 256; tt[2 * (b + m)] = tid | (nr << 8); tt[2 * (b + m) + 1] = s + m * 256; } }
    __syncthreads();
    return tb[32];
}

struct DownConvHook {
    static constexpr bool ON = true; static constexpr int I_E = 8 * 32, NDOWN = 32 * I_E;
    const float* p_wd; unsigned char* ws; gu32* cnt; int cls;
    __device__ __forceinline__ void pair(int lane) const {
        int u0 = 0; if (lane == 0) u0 = (int)__hip_atomic_fetch_add(cnt, 2u, RLX_AGENT);
        u0 = __builtin_amdgcn_readfirstlane(u0); if (u0 >= NDOWN) return;
        const int e = u0 / I_E, q = u0 % I_E;
        const TrJob ja{p_wd + (size_t)e * 1048576, nullptr, (bf16_t*)(ws + WS_WDT + (size_t)e * 1024 * 1024), 1024, 1024, (q / 32) * 128, (q % 32) * 32, -1, 1};
        TrJob jb = ja; jb.n0 += 32;
        const f32x4 s32 = (f32x4){32.f, 32.f, 32.f, 32.f}; const f32x4 sc[4] = {s32, s32, s32, s32};
        f32x4 va[16], vb[16]; transpose8_load(ja, lane, va); transpose8_load(jb, lane, vb);
        transpose8_store_sc(ja, lane, va, sc); transpose8_store_sc(jb, lane, vb, sc); }
    __device__ __forceinline__ void operator()(int ui) const {
        if ((ui & 3) != cls) return;
        int lane_ = threadIdx.x; asm volatile("" : "+v"(lane_)); pair(lane_ & 63); }
};

template <int PHM>
__global__ void __launch_bounds__(NTHREADS, 2) mk_fwd(Args args) {
    extern __shared__ __attribute__((aligned(16))) unsigned char lds_raw[];
    LAS unsigned char* lds = (LAS unsigned char*)lds_raw;
    volatile LAS unsigned* MISC = (volatile LAS unsigned*)(lds + LDS_MISC);
    const int tid = threadIdx.x, lane = tid & 63, wave = __builtin_amdgcn_readfirstlane(tid >> 6);
    const int G = gridDim.x; int bx = blockIdx.x; int vcu = (G % 8 == 0) ? (bx % 8) * (G / 8) + bx / 8 : bx;
    bool xl_ok = false; unsigned xl_x = 0u;
    unsigned char* ws = args.ws;
#define ctl ((gu32*)(ws + WS_CTL))
    if (tid < 64) MISC[tid] = 0u;
    __syncthreads();
    if (MK_N_LAUNCHES == 1) (void)xcd_barrier_post((unsigned*)(ws + WS_CTL) + CW_BAR, (volatile LAS unsigned*)(lds + LDS_MISC) + 8);
#define GRID_BAR() do { if (MK_N_LAUNCHES == 1) { XcdBarrier bar_; bar_.bar = (unsigned*)(ws + WS_CTL) + CW_BAR; bar_.x = xb_xcc_id(); bar_.st = (volatile LAS unsigned*)(lds + LDS_MISC) + 8; xcd_barrier(bar_); } } while (0)
#define SEAM_BAR(k) do { if (xl_ok) xcd_local_barrier((unsigned*)(ws + WS_CTL) + CW_BAR, xl_x, (unsigned)(G / 8) * (unsigned)(k)); else GRID_BAR(); } while (0)
#define IN(k) ((PHM >> (k)) & 1)
#define Xin ((const float*)INP(0))
#define rs1 ((float*)(ws + WS_RS1))
#define rs2 ((float*)(ws + WS_RS2))
#define tope ((int*)(ws + WS_TOPE))
#define topg ((float*)(ws + WS_TOPG))
#define spos ((int*)(ws + WS_SPOS))
#define srow ((int*)(ws + WS_SROW))
#define rtok ((int*)(ws + WS_RTOK))
#define rgate ((float*)(ws + WS_RGATE))
#define rrs ((float*)(ws + WS_RRS))
#define XB ((bf16_t*)(ws + WS_H1B))
#define H1b ((bf16_t*)(ws + WS_H1B))
#define WinT ((bf16_t*)(ws + WS_WINT))
#define WgluT ((bf16_t*)(ws + WS_WGLUT))
#define WaT ((bf16_t*)(ws + WS_WAT))
#define WoT ((bf16_t*)(ws + WS_WOT))
#define Wm ((bf16_t*)(ws + WS_WM))
#define AS5 ((bf16_t*)(ws + WS_AS5))
#define Ub ((bf16_t*)(ws + WS_U))
#define Vb ((bf16_t*)(ws + WS_V))
#define Zb ((bf16_t*)(ws + WS_Z))
#define YAB ((bf16_t*)(ws + WS_YAB))
#define GA ((bf16_t*)args.out)
#define GB ((bf16_t*)args.out + (size_t)T * 1024)
#define SST ((float*)(ws + WS_SST))
#define MRG ((bf16_t*)(ws + WS_MRG))
#define gw (vcu * NWAVES + wave)
#define NGW (G * NWAVES)

    if (IN(0)) {
        if (vcu < 32) s5_build_group(args, vcu, lds, tid);
        constexpr int I_IN = 8 * 16 * INP_NF8, I_INB = 16 * 16 * INP_NBF, I_IN8 = 8 * 64, I_GLU = 8 * 16, I_A = 8 * 32, I_B = 8 * 32, I_O = 16 * 32, I_E = 8 * 32;
        constexpr int NSMALL = I_INB + I_GLU + I_A + I_B + I_O, NITEMS = NSMALL + I_IN8 + I_IN, NXU = T / 2;
        const float *p_win = INP(2), *p_g1 = INP(1), *p_glu = INP(11), *p_wa = INP(17), *p_wb = INP(18), *p_wo = INP(19), *p_x = INP(0);
        auto mkjob = [&](int r) -> TrJob { TrJob j; constexpr int f8g[4] = INP_F8_GROUPS, bfg[4] = INP_BF_GROUPS;
            if (r < I_INB) { const int n0 = (r % (16 * INP_NBF)) * 32, gc = bfg[n0 >> 9] * 512 + (n0 & 511); j = TrJob{p_win + (gc - n0), p_g1, (bf16_t*)(ws + WS_WINT + (2u << 20)), INW, 1024, (r / (16 * INP_NBF)) * 64, n0, -1, 0}; return j; } r -= I_INB;
            if (r < I_GLU) { j = TrJob{p_glu, nullptr, WgluT, 512, 512, (r / 16) * 64, (r % 16) * 32, -1, 0}; return j; } r -= I_GLU;
            if (r < I_A) { j = TrJob{p_wa, nullptr, WaT, 1024, 1024, (r / 32) * 64, (r % 32) * 32, -1, 0}; return j; } r -= I_A;
            if (r < I_B) { j = TrJob{p_wb, nullptr, WaT + 512, 1024, 1024, (r / 32) * 64, (r % 32) * 32, -1, 0}; return j; } r -= I_B;
            if (r < I_O) { j = TrJob{p_wo, nullptr, WoT, 1024, 1024, (r / 32) * 64, (r % 32) * 32, -1, 0}; return j; } r -= I_O;
            if (r < I_IN) { const int n0 = (r % (16 * INP_NF8)) * 32, gc = f8g[n0 >> 9] * 512 + (n0 & 511); j = TrJob{p_win + (gc - n0), p_g1, WinT, INW, 1024, (r / (16 * INP_NF8)) * 128, n0, -1, 1}; return j; } r -= I_IN;
            const int nb = r % 64; j = TrJob{p_win + (nb < 32 ? 1536 : 2560), p_g1, (bf16_t*)(ws + WS_WINT8), INW, 1024, (r / 64) * 128, (nb & 31) * 32, nb < 32 ? 0 : 128, 1}; return j; };
        for (;;) {
            int u0 = 0; if (lane == 0) u0 = (int)__hip_atomic_fetch_add(ctl + CW_CNT + 64, 4u, RLX_AGENT);
            u0 = __builtin_amdgcn_readfirstlane(u0); if (u0 >= NITEMS) break;
            for (int p = 0; p < 4; p += 2) { const int i0 = u0 + p, i1 = i0 + 1;
                if (i0 < NSMALL) { const TrJob ja = mkjob(i0), jb = mkjob(i1); f32x4 va[8], vb[8]; transpose_load(ja, lane, va); transpose_load(jb, lane, vb); transpose_store(ja, lane, va); transpose_store(jb, lane, vb); }
                else { const TrJob ja = mkjob(i0), jb = mkjob(i1); f32x4 va[16], vb[16]; transpose8_load(ja, lane, va); transpose8_load(jb, lane, vb); transpose8_store(ja, lane, va); transpose8_store(jb, lane, vb); } }
        }
        for (;;) {
            int u0 = 0; if (lane == 0) u0 = (int)__hip_atomic_fetch_add(ctl + CW_CNT + 192, 8u, RLX_AGENT);
            u0 = __builtin_amdgcn_readfirstlane(u0); if (u0 >= NXU) break;
            for (int p = 0; p < 8; p += 2) { const int m = (p >> 1) * (T / 4) + (u0 >> 1);
                const f32x4* xr = (const f32x4*)(p_x + (size_t)m * D) + 2 * lane; f32x4 v[16]; float s[4] = {0.f, 0.f, 0.f, 0.f};
#pragma unroll
                for (int q = 0; q < 4; ++q)
#pragma unroll
                    for (int j = 0; j < 2; ++j) { v[4 * q + 2 * j] = __builtin_nontemporal_load(xr + 256 * q + 128 * j); v[4 * q + 2 * j + 1] = __builtin_nontemporal_load(xr + 256 * q + 128 * j + 1); }
#pragma unroll
                for (int q = 0; q < 4; ++q)
#pragma unroll
                    for (int j = 0; j < 4; ++j) { const f32x4 w = v[4 * q + j]; s[q] += (w.x * w.x + w.y * w.y) + (w.z * w.z + w.w * w.w); }
#pragma unroll
                for (int o = 1; o < 64; o <<= 1) { s[0] += __shfl_xor(s[0], o); s[1] += __shfl_xor(s[1], o); s[2] += __shfl_xor(s[2], o); s[3] += __shfl_xor(s[3], o); }
                if (lane < 4) { const float sv = lane == 0 ? s[0] : (lane == 1 ? s[1] : (lane == 2 ? s[2] : s[3])); rs1[m + lane] = 1.0f / sqrtf(sv * (1.0f / D) + NORM_EPS); }
                u32x4* o = (u32x4*)(XB + (size_t)m * D) + lane; u32x2* o8 = (u32x2*)(ws + WS_H1F8 + (size_t)m * D) + lane;
#pragma unroll
                for (int q = 0; q < 4; ++q)
#pragma unroll
                    for (int j = 0; j < 2; ++j) { const f32x4 w0 = v[4 * q + 2 * j], w1 = v[4 * q + 2 * j + 1]; o[128 * q + 64 * j] = pack8(w0, w1); o8[128 * q + 64 * j] = pack8_f8(w0, w1); } }
        }
        { const float* bgp = INP(24); const float* bup_ = INP(26); const float* bdp = INP(28); const float* blp = INP(12);
          for (int i = vcu * NTHREADS + tid; i < 32768; i += G * NTHREADS) { ((float*)(ws + WS_BG))[i] = bgp[i] * MOE_KSG; ((float*)(ws + WS_BU))[i] = (bup_[i] + 1.0f) * (1.0f / MOE_KSG); ((float*)(ws + WS_BD))[i] = bdp[i]; if (i < 512) ((float*)(ws + WS_BGLU))[i] = blp[i];
              if (i < 16384) { const int kp = i >> 5, e = i & 31; const float* wr_ = INP(21); const float* g2 = INP(20); const float w0 = wr_[(2 * kp) * 32 + e] * g2[2 * kp], w1 = wr_[(2 * kp + 1) * 32 + e] * g2[2 * kp + 1];
                  const unsigned hi = cvt_pk_bf16(w0, w1); const unsigned lo = cvt_pk_bf16(w0 - bflo(hi), w1 - bfhi(hi));
                  *(unsigned*)(ws + WS_WRIMG + e * 2064 + 4 * kp) = hi; *(unsigned*)(ws + WS_WRIMG + 32 * 2064 + e * 2064 + 4 * kp) = lo; }
              if (i < 1024) { const float g2v = INP(20)[i]; ((float*)(ws + WS_G2S))[i] = g2v * MOE_KSG; ((float*)(ws + WS_G2S))[1024 + i] = g2v * (1.0f / MOE_KSG); } } }
        for (int i = vcu * NTHREADS + tid; i < 4 * 128 * 128; i += G * NTHREADS) { const int ii = (i >> 7) & 127, jj = i & 127; const float w = ((ii >> 6) >= (jj >> 6)) ? INP(15)[i] : 0.f; Wm[i] = (bf16_t)(cvt_pk_bf16(w, 0.f) & 0xffffu); }
        GRID_BAR();
        if (MK_N_LAUNCHES == 1 && __builtin_amdgcn_readfirstlane((int)MISC[10]) != 0) {
            xl_ok = true; xl_x = xb_xcc_id(); const int rk = __builtin_amdgcn_readfirstlane((int)MISC[11]);
            bx = rk * 8 + (int)xl_x; vcu = (int)xl_x * (G / 8) + rk; }
    }

    if (IN(1)) {
        constexpr int f8g[4] = INP_F8_GROUPS, bfg[4] = INP_BF_GROUPS;
        constexpr int I_E = 8 * 32, NMOE = 64 * I_E, GRABM = 4, QUOTA = 2;
        const int cls = (G == 256) ? ((bx >> 3) & 3) : 3;
#pragma unroll 1
        for (int stage = 0; stage < 4; ++stage) {
            const int quota = stage == 3 ? (1 << 30) : (stage == cls ? QUOTA : 0);
            if (quota > 0) { int lane_ = threadIdx.x; asm volatile("" : "+v"(lane_)); const int lane = lane_ & 63;
        const float *p_g2 = (const float*)(ws + WS_G2S), *p_wg = INP(23), *p_wu = INP(25), *p_wd = INP(27);
            auto mkmoe = [&](int r) -> TrJob { TrJob j; const int ty = r / (32 * I_E), e = (r / I_E) % 32, q = r % I_E, k0 = (q / 32) * 128, n0 = (q % 32) * 32;
                if (ty == 0) j = TrJob{p_wg + (size_t)e * 1048576, p_g2, (bf16_t*)(ws + WS_W1T + (size_t)e * 2048 * 1024), 1024, 1024, k0, n0, 0, 1};
                else if (ty == 1) j = TrJob{p_wu + (size_t)e * 1048576, p_g2 + 1024, (bf16_t*)(ws + WS_W1T + (size_t)e * 2048 * 1024), 1024, 1024, k0, n0, 128, 1};
                else j = TrJob{p_wd + (size_t)e * 1048576, nullptr, (bf16_t*)(ws + WS_WDT + (size_t)e * 1024 * 1024), 1024, 1024, k0, n0, -1, 1};
                return j; };
            for (int gq = 0; gq < quota; ++gq) {
                int u0 = 0; if (lane == 0) u0 = (int)__hip_atomic_fetch_add(ctl + CW_CNT + 128, (unsigned)GRABM, RLX_AGENT);
                u0 = __builtin_amdgcn_readfirstlane(u0); if (u0 >= NMOE) break;
                const TrJob j0 = mkmoe(u0); f32x4 sc[4];
#pragma unroll
                for (int q = 0; q < 4; ++q) sc[q] = (j0.ks ? *(const f32x4*)(j0.ks + j0.k0 + 16 * (lane >> 3) + 4 * q) : (f32x4){1.f, 1.f, 1.f, 1.f}) * 32.0f;
                for (int p = 0; p < GRABM; p += 2) { const TrJob ja = mkmoe(u0 + p), jb = mkmoe(u0 + p + 1); f32x4 va[16], vb[16]; transpose8_load(ja, lane, va); transpose8_load(jb, lane, vb);
                    transpose8_store_sc(ja, lane, va, sc); transpose8_store_sc(jb, lane, vb, sc); } } }
            __syncthreads();
            if (stage == 0) { if (INP_NBF > 0) { pg8::DenseSched S; S.init(WS_H1B, WS_WINT + (2u << 20), T, 512 * INP_NBF, D, D, G, bx);
                int pm_ = 0; for (int q = 0; q < 2 * INP_NBF; ++q) pm_ |= (2 * bfg[q >> 1] + (q & 1)) << (4 * q);
                pg8::EpiInProj E{AS5, Ub, Vb, pm_, 1.0f};
                pg8::gemm_phase(lds, ws, S, E); } }
            else if (stage == 1) { if (INP_NF8 > 0) { pg8::DenseSchedT<true> S; S.init(WS_H1F8, WS_WINT, T, 512 * INP_NF8, D, D, G, bx);
                int pm_ = 0; for (int q = 0; q < 2 * INP_NF8; ++q) pm_ |= (2 * f8g[q >> 1] + (q & 1)) << (4 * q);
                pg8::EpiInProj E{AS5, Ub, Vb, pm_, 0.03125f};
                pg8::gemm_phase(lds, ws, S, E); } }
            else if (stage == 2) { pg8::DenseSchedT<true> S; S.init(WS_H1F8, WS_WINT8, T, 2048, D, D, G, bx);
                pg8::EpiGates E{GA, GB};
                pg8::gemm_phase(lds, ws, S, E); }
        }
        GRID_BAR();
    }

    if (IN(2)) {
        { pg8::S5Sched S; S.init(WS_AS5, WS_W1S, 256, vcu); pg8::EpiS5End E{SST}; pg8::gemm_phase(lds, ws, S, E); }

        for (int item = vcu; item < 256; item += G) {
            const int t0 = item * 128; constexpr int RS = 1056;
            const float* lng = INP(13); const float* lnb = INP(14); const float* bs = INP(16);
            const f32x4 g0 = *(const f32x4*)(lng + lane * 8), g1 = *(const f32x4*)(lng + lane * 8 + 4), b0 = *(const f32x4*)(lnb + lane * 8), b1 = *(const f32x4*)(lnb + lane * 8 + 4);
            u32x4 raw[16]; float sm[16], sq[16];
#pragma unroll
            for (int r = 0; r < 16; ++r) raw[r] = *(const u32x4*)(Vb + (size_t)(t0 + wave * 16 + r) * 512 + lane * 8);
#pragma unroll
            for (int r = 0; r < 16; ++r) { f32x4 v0, v1; unpack8(raw[r], v0, v1); sm[r] = (v0[0] + v0[1]) + (v0[2] + v0[3]) + (v1[0] + v1[1]) + (v1[2] + v1[3]); }
#pragma unroll
            for (int o = 1; o < 64; o <<= 1)
#pragma unroll
                for (int r = 0; r < 16; ++r) sm[r] += __shfl_xor(sm[r], o);
#pragma unroll
            for (int r = 0; r < 16; ++r) { f32x4 v0, v1; unpack8(raw[r], v0, v1); const float mean = sm[r] * (1.0f / 512.0f); v0 -= mean; v1 -= mean;
                sq[r] = (v0[0] * v0[0] + v0[1] * v0[1]) + (v0[2] * v0[2] + v0[3] * v0[3]) + (v1[0] * v1[0] + v1[1] * v1[1]) + (v1[2] * v1[2] + v1[3] * v1[3]); }
#pragma unroll
            for (int o = 1; o < 64; o <<= 1)
#pragma unroll
                for (int r = 0; r < 16; ++r) sq[r] += __shfl_xor(sq[r], o);
#pragma unroll
            for (int r = 0; r < 16; ++r) { f32x4 v0, v1; unpack8(raw[r], v0, v1); const float mean = sm[r] * (1.0f / 512.0f), rstd = 1.0f / sqrtf(sq[r] * (1.0f / 512.0f) + NORM_EPS);
                v0 = (v0 - mean) * rstd * g0 + b0; v1 = (v1 - mean) * rstd * g1 + b1;
                *(LAS u32x4*)(lds + (wave * 16 + r) * RS + lane * 16) = pack8(v0, v1); }
            __syncthreads();
            const int i0 = wave * 16, fr = lane & 15, fq = lane >> 4;
            bf16x8 wf[4], wn[4]; u32x4 uf[4], un[4];
            const bf16_t* urow = Ub + (size_t)(t0 + i0 + fr) * 512 + (fq & 1) * 16 + 8 * (fq >> 1);
#pragma unroll
            for (int ks = 0; ks < 4; ++ks) wf[ks] = *(const bf16x8*)(Wm + ((size_t)0 * 128 + i0 + fr) * 128 + ks * 32 + fq * 8);
#pragma unroll
            for (int j = 0; j < 4; ++j) uf[j] = *(const u32x4*)(urow + j * 32);
            for (int h = 0; h < 4; ++h) {
                const int hn = h < 3 ? h + 1 : 3;
#pragma unroll
                for (int ks = 0; ks < 4; ++ks) wn[ks] = *(const bf16x8*)(Wm + ((size_t)hn * 128 + i0 + fr) * 128 + ks * 32 + fq * 8);
#pragma unroll
                for (int j = 0; j < 4; ++j) un[j] = *(const u32x4*)(urow + hn * 128 + j * 32);
                const float bias = bs[h * 128 + i0 + fr];
#pragma unroll
                for (int j = 0; j < 4; ++j) { u32x2 o2[2];
                    const auto s0 = __builtin_amdgcn_permlane16_swap(uf[j].x, uf[j].z, false, false), s1 = __builtin_amdgcn_permlane16_swap(uf[j].y, uf[j].w, false, false);
                    const u32x2 uw2[2] = {(u32x2){s0[0], s1[0]}, (u32x2){s0[1], s1[1]}};
#pragma unroll
                    for (int q = 0; q < 2; ++q) { const int cb = 2 * j + q; f32x4 a = (f32x4){0.f, 0.f, 0.f, 0.f}; const int c0 = h * 128 + cb * 16;
#pragma unroll
                        for (int ks = 0; ks < 4; ++ks) {
                            const LAS unsigned char* p = lds + (ks * 32 + fq * 8 + (fr >> 2)) * RS + (c0 + 4 * (fr & 3)) * 2;
                            const s16x4 lo4 = __builtin_bit_cast(s16x4, __builtin_amdgcn_ds_read_tr16_b64_v4i16((LAS s16x4*)p));
                            const s16x4 hi4 = __builtin_bit_cast(s16x4, __builtin_amdgcn_ds_read_tr16_b64_v4i16((LAS s16x4*)(p + 4 * RS)));
                            const bf16x8 vf = (bf16x8){lo4[0], lo4[1], lo4[2], lo4[3], hi4[0], hi4[1], hi4[2], hi4[3]};
                            a = __builtin_amdgcn_mfma_f32_16x16x32_bf16(vf, wf[ks], a, 0, 0, 0); }
                        o2[q].x = cvt_pk_bf16(bflo(uw2[q].x) * (a[0] + bias), bfhi(uw2[q].x) * (a[1] + bias)); o2[q].y = cvt_pk_bf16(bflo(uw2[q].y) * (a[2] + bias), bfhi(uw2[q].y) * (a[3] + bias)); }
                    *(u32x4*)(YAB + (size_t)(t0 + i0 + fr) * 1024 + 512 + h * 128 + (2 * j + (fq & 1)) * 16 + 8 * (fq >> 1)) = pair16_f8(o2[0], o2[1]); }
#pragma unroll
                for (int ks = 0; ks < 4; ++ks) wf[ks] = wn[ks];
#pragma unroll
                for (int j = 0; j < 4; ++j) uf[j] = un[j];
            }
            __syncthreads();
        }

        SEAM_BAR(1);
    }

    if (IN(3)) {
        for (int item = vcu; item < 256; item += G) {
            const int g = item >> 3, b = (item >> 1) & 3, nh = item & 1;
            LAS float* sm = (LAS float*)lds;
            LAS f32x2* Eb = (LAS f32x2*)(lds + 131072);
            { f32x4 t[16];
#pragma unroll
              for (int j = 0; j < 16; ++j) { const int i = tid + j * NTHREADS, c = i >> 4, part = (i >> 3) & 1, q = i & 7; t[j] = *(const f32x4*)(SST + (size_t)(b * 512 + c) * 4096 + g * 128 + part * 64 + nh * 32 + q * 4); }
#pragma unroll
              for (int j = 0; j < 16; ++j) { const int i = tid + j * NTHREADS, c = i >> 4, part = (i >> 3) & 1, q = i & 7; *(LAS f32x4*)(sm + c * 64 + part * 32 + q * 4) = t[j]; } }
            __syncthreads();
            const int seg = tid >> 5, nl = tid & 31, n = nh * 32 + nl; const f32x2* lamtab = (const f32x2*)(ws + WS_LAM);
            const f32x2 l16 = lamtab[g * 64 + n], l512 = lamtab[2048 + g * 64 + n];
            float sr = 0.f, si = 0.f;
            for (int c = seg * 32; c < seg * 32 + 32; ++c) { const float xr = sm[c * 64 + nl], xi = sm[c * 64 + 32 + nl]; const float tr = l16.x * sr - l16.y * si + xr, ti = l16.x * si + l16.y * sr + xi; sr = tr; si = ti; }
            Eb[seg * 32 + nl] = (f32x2){sr, si};
            __syncthreads();
            sr = 0.f; si = 0.f;
            for (int s = 0; s < seg; ++s) { const f32x2 e = Eb[s * 32 + nl]; const float tr = l512.x * sr - l512.y * si + e.x, ti = l512.x * si + l512.y * sr + e.y; sr = tr; si = ti; }
            for (int c = seg * 32; c < seg * 32 + 32; ++c) {
                const float xr = sm[c * 64 + nl], xi = sm[c * 64 + 32 + nl]; sm[c * 64 + nl] = sr; sm[c * 64 + 32 + nl] = si;
                const float tr = l16.x * sr - l16.y * si + xr, ti = l16.x * si + l16.y * sr + xi; sr = tr; si = ti; }
            __syncthreads();
            { bf16_t* dst = AS5 + ((size_t)g * 2048 + (size_t)b * 512) * AS5_LD + 256 + nh * 32;
#pragma unroll
              for (int j = 0; j < 8; ++j) { const int p = tid + j * NTHREADS, c = p >> 3, sub = p & 7; const LAS float* sp = sm + c * 64 + (sub >> 2) * 32 + (sub & 3) * 8;
                  *(u32x4*)(dst + (size_t)c * AS5_LD + (sub >> 2) * 64 + (sub & 3) * 8) = pack8(*(const LAS f32x4*)sp, *(const LAS f32x4*)(sp + 4)); } }
            __syncthreads();
        }
        SEAM_BAR(2);
    }

    if (IN(4)) {
        pg8::S5Sched S; S.init(WS_AS5, WS_MT, 384, vcu); pg8::EpiS5Out E{Zb}; pg8::gemm_phase(lds, ws, S, E);
        GRID_BAR();
    }
    if (IN(5)) {
        pg8::DenseSched S; S.init(WS_Z, WS_WGLUT, T, 512, 512, 512, G, bx); pg8::EpiGlu E{Zb, INP(12), YAB}; pg8::gemm_phase(lds, ws, S, E);
        SEAM_BAR(3);
    }
    if (IN(6)) {
        pg8::DenseSched S; S.init(WS_YAB, WS_WAT, T, D, D, D, G, bx); pg8::EpiMerge E{GA, GB, MRG}; pg8::gemm_phase(lds, ws, S, E);
        SEAM_BAR(4);
    }
    if (IN(7)) {
        pg8::DenseSched S; S.init(WS_MRG, WS_WOT, T, D, D, D, G, bx); pg8::EpiOutProj E{H1b, ws + WS_H1F8}; pg8::gemm_phase(lds, ws, S, E);
        SEAM_BAR(5);
    }
    if (IN(8)) {
        constexpr int WRS = 2064;
        LAS unsigned char* WRhi = lds; LAS unsigned char* WRlo = lds + 32 * WRS;
        LAS int* hist = (LAS int*)(lds + LDS_X + 20480); LAS int* hbase = hist + 32;
        { const u32x4* img = (const u32x4*)(ws + WS_WRIMG) + tid; u32x4 t[16], tl = (u32x4){0u, 0u, 0u, 0u};
#pragma unroll
          for (int j = 0; j < 16; ++j) t[j] = img[j * NTHREADS];
          if (tid < 132096 / 16 - 16 * NTHREADS) tl = img[16 * NTHREADS];
#pragma unroll
          for (int j = 0; j < 16; ++j) *(LAS u32x4*)(lds + (tid + j * NTHREADS) * 16) = t[j];
          if (tid < 132096 / 16 - 16 * NTHREADS) *(LAS u32x4*)(lds + (tid + 16 * NTHREADS) * 16) = tl; }
        if (tid < 32) hist[tid] = 0;
        __syncthreads();
        const float* brt = INP(22);
        for (int blk = vcu; blk < 256; blk += G) {
            int e4[4] = {0, 0, 0, 0}, lp4[4] = {0, 0, 0, 0}; float gt4[4] = {0.f, 0.f, 0.f, 0.f}, rsv = 0.f; const int tok0 = blk * 128 + wave * 32; const int hi = lane >> 5, li = lane & 31;
            if (wave < 4) {
                LAS float* scr = (LAS float*)(lds + 132096 + wave * 4608);
                const bf16_t* hrow = H1b + (size_t)(tok0 + li) * 1024 + 8 * hi;
                const LAS unsigned char* bh = WRhi + li * WRS + 16 * hi; const LAS unsigned char* bl = WRlo + li * WRS + 16 * hi;
                f32x16 acc; for (int r = 0; r < 16; ++r) acc[r] = 0.f; float ssq = 0.f;
#pragma unroll 8
                for (int s = 0; s < 64; ++s) { const u32x4 av = *(const u32x4*)(hrow + 16 * s);
                    ssq += (bflo(av.x) * bflo(av.x) + bfhi(av.x) * bfhi(av.x)) + (bflo(av.y) * bflo(av.y) + bfhi(av.y) * bfhi(av.y)) + (bflo(av.z) * bflo(av.z) + bfhi(av.z) * bfhi(av.z)) + (bflo(av.w) * bflo(av.w) + bfhi(av.w) * bfhi(av.w));
                    const bf16x8 a = __builtin_bit_cast(bf16x8, av);
                    acc = __builtin_amdgcn_mfma_f32_32x32x16_bf16(a, *(const LAS bf16x8*)(bh + 32 * s), acc, 0, 0, 0);
                    acc = __builtin_amdgcn_mfma_f32_32x32x16_bf16(a, *(const LAS bf16x8*)(bl + 32 * s), acc, 0, 0, 0); }
                ssq += __shfl_xor(ssq, 32);
#pragma unroll
                for (int r = 0; r < 16; ++r) scr[((r & 3) + 8 * (r >> 2) + 4 * hi) * 33 + li] = acc[r];
                LDS_WAIT(); asm volatile("" ::: "memory");
                if (lane < 32) { const float rs = 1.0f / sqrtf(ssq * (1.0f / 1024.0f) + NORM_EPS); rsv = rs;
                    float v4[4]; int i0 = -1, i1 = -1, i2 = -1;
#pragma unroll
                    for (int k = 0; k < 4; ++k) { float best = -INFINITY; int bi = 0;
                        for (int e = 0; e < 32; ++e) { const float l = scr[lane * 33 + e] * rs + brt[e]; const bool ok = (e != i0) && (e != i1) && (e != i2); if (ok && l > best) { best = l; bi = e; } }
                        v4[k] = best; e4[k] = bi; if (k == 0) i0 = bi; else if (k == 1) i1 = bi; else if (k == 2) i2 = bi; }
                    const float p1 = __expf(v4[1] - v4[0]), p2 = __expf(v4[2] - v4[0]), p3 = __expf(v4[3] - v4[0]); const float inv = 1.0f / (1.0f + p1 + p2 + p3);
                    gt4[0] = inv; gt4[1] = p1 * inv; gt4[2] = p2 * inv; gt4[3] = p3 * inv;
#pragma unroll
                    for (int k = 0; k < 4; ++k) lp4[k] = __hip_atomic_fetch_add((int*)(hist + e4[k]), 1, __ATOMIC_RELAXED, __HIP_MEMORY_SCOPE_WORKGROUP); }
            }
            __syncthreads();
            if (tid < 32) { const int c = hist[tid]; hbase[tid] = c ? (int)__hip_atomic_fetch_add(ctl + CW_CNT + tid, (unsigned)c, RLX_AGENT) : 0; hist[tid] = 0; }
            __syncthreads();
            if (wave < 4 && lane < 32) { const int t = tok0 + lane;
#pragma unroll
                for (int k = 0; k < 4; ++k) { const int pos = hbase[e4[k]] + lp4[k], ix = e4[k] * T + pos; lp4[k] = pos;
                    ((int*)(ws + WS_RT2))[ix] = t; ((float*)(ws + WS_RG2))[ix] = gt4[k]; ((float*)(ws + WS_RR2))[ix] = rsv; }
                *(int4*)(tope + t * 4) = make_int4(e4[0], e4[1], e4[2], e4[3]); *(int4*)(spos + t * 4) = make_int4(lp4[0], lp4[1], lp4[2], lp4[3]); }
            __syncthreads();
        }
        GRID_BAR();
    }
    if (IN(10)) {
        LAS int* tt = (LAS int*)(lds + LDS_X); const int ntiles = moe_build_tiles(ctl + CW_CNT, tt, tid);
        pg8::MoeSched1 S; S.A = (unsigned)WS_H1F8; S.Bt = (unsigned)WS_W1T; S.rtk = (const int*)(ws + WS_RT2); S.tt = tt; S.lda2 = 1024u; S.K2 = 1024u; S.hstepA = 0u; S.nt = 8; S.ntiles = ntiles; S.G = G; S.vc = vcu;
        pg8::EpiMoe1 E{rrs, INP(24), INP(26), ws + WS_HWS, ws + WS_TRASH};
        const DownConvHook H{INP(27), ws, ctl + CW_CNT + 160, (vcu >> 3) & 3};
        pg8::gemm_phase(lds, ws, S, E, H);
        { int lane_ = threadIdx.x; asm volatile("" : "+v"(lane_)); const int ln = lane_ & 63;
          while (__hip_atomic_load(ctl + CW_CNT + 160, RLX_AGENT) < (unsigned)DownConvHook::NDOWN) H.pair(ln); }
        GRID_BAR();
    }
    if (IN(11)) {
        LAS int* tt = (LAS int*)(lds + LDS_X); const int ntiles = moe_build_tiles(ctl + CW_CNT, tt, tid);
        pg8::MoeSched2 S; S.Ahi = (unsigned)WS_HWS; S.Bt = (unsigned)WS_WDT; S.tt = tt; S.lda2 = 1024u; S.K2 = 1024u; S.hstepA = 128u * 1024u; S.nt = 8; S.ntiles = ntiles; S.G = G; S.vc = vcu;
        pg8::EpiMoe2 E{rgate, INP(28), ws + WS_Y, ws + WS_TRASH}; pg8::gemm_phase(lds, ws, S, E);
        GRID_BAR();
    }
    if (IN(12)) {
        LAS int* ttf = (LAS int*)(lds + LDS_X); (void)moe_build_tiles(ctl + CW_CNT, ttf, tid); const LAS int* st = ttf + 1432;
        const float* gf = INP(29);
        const f32x4 gf0 = *(const f32x4*)(gf + lane * 8), gf1 = *(const f32x4*)(gf + lane * 8 + 4), gf2 = *(const f32x4*)(gf + 512 + lane * 8), gf3 = *(const f32x4*)(gf + 512 + lane * 8 + 4);
        u32x4 cur[2], nxt[2]; u32x2 ycur[8], ynxt[8];
#define P12_LOAD(dst, ydst, tt) do { const int4 te_ = *(const int4*)(tope + (size_t)(tt) * 4), sp_ = *(const int4*)(spos + (size_t)(tt) * 4); const int r0_ = __builtin_amdgcn_readfirstlane(st[te_.x] + sp_.x), r1_ = __builtin_amdgcn_readfirstlane(st[te_.y] + sp_.y), r2_ = __builtin_amdgcn_readfirstlane(st[te_.z] + sp_.z), r3_ = __builtin_amdgcn_readfirstlane(st[te_.w] + sp_.w); \
            const unsigned char* Y8_ = ws + WS_Y + lane * 8; \
            dst[0] = __builtin_nontemporal_load((const u32x4*)(H1b + (size_t)(tt) * 1024 + lane * 8)); dst[1] = __builtin_nontemporal_load((const u32x4*)(H1b + (size_t)(tt) * 1024 + 512 + lane * 8)); \
            ydst[0] = __builtin_nontemporal_load((const u32x2*)(Y8_ + (size_t)r0_ * 1024)); ydst[1] = __builtin_nontemporal_load((const u32x2*)(Y8_ + (size_t)r0_ * 1024 + 512)); \
            ydst[2] = __builtin_nontemporal_load((const u32x2*)(Y8_ + (size_t)r1_ * 1024)); ydst[3] = __builtin_nontemporal_load((const u32x2*)(Y8_ + (size_t)r1_ * 1024 + 512)); \
            ydst[4] = __builtin_nontemporal_load((const u32x2*)(Y8_ + (size_t)r2_ * 1024)); ydst[5] = __builtin_nontemporal_load((const u32x2*)(Y8_ + (size_t)r2_ * 1024 + 512)); \
            ydst[6] = __builtin_nontemporal_load((const u32x2*)(Y8_ + (size_t)r3_ * 1024)); ydst[7] = __builtin_nontemporal_load((const u32x2*)(Y8_ + (size_t)r3_ * 1024 + 512)); } while (0)
#define P12_ADD8(w, lo4, hi4) do { const f32x2 q0_ = __builtin_amdgcn_cvt_pk_f32_fp8((int)(w).x, false), q1_ = __builtin_amdgcn_cvt_pk_f32_fp8((int)(w).x, true), q2_ = __builtin_amdgcn_cvt_pk_f32_fp8((int)(w).y, false), q3_ = __builtin_amdgcn_cvt_pk_f32_fp8((int)(w).y, true); \
            lo4 += (f32x4){q0_.x, q0_.y, q1_.x, q1_.y} * 0.0625f; hi4 += (f32x4){q2_.x, q2_.y, q3_.x, q3_.y} * 0.0625f; } while (0)
        int t = gw;
        if (t < T) P12_LOAD(cur, ycur, t);
        for (; t < T; t += NGW) {
            const int tn = t + NGW; const bool hn = tn < T;
            if (hn) P12_LOAD(nxt, ynxt, tn);
            f32x4 a0, a1, a2, a3; unpack8(cur[0], a0, a1); unpack8(cur[1], a2, a3);
#pragma unroll
            for (int k = 0; k < 4; ++k) { P12_ADD8(ycur[2 * k], a0, a1); P12_ADD8(ycur[2 * k + 1], a2, a3); }
            float s = 0.f;
#pragma unroll
            for (int j = 0; j < 4; ++j) s += a0[j] * a0[j] + a1[j] * a1[j] + a2[j] * a2[j] + a3[j] * a3[j];
            const float rs = 1.0f / sqrtf(wave_sum(s) * (1.0f / 1024.0f) + NORM_EPS);
            float* o = args.out + (size_t)t * 1024 + lane * 8;
            __builtin_nontemporal_store(a0 * rs * gf0, (f32x4*)o); __builtin_nontemporal_store(a1 * rs * gf1, (f32x4*)(o + 4)); __builtin_nontemporal_store(a2 * rs * gf2, (f32x4*)(o + 512)); __builtin_nontemporal_store(a3 * rs * gf3, (f32x4*)(o + 516));
            if (hn) { cur[0] = nxt[0]; cur[1] = nxt[1];
#pragma unroll
                for (int i = 0; i < 8; ++i) ycur[i] = ynxt[i]; }
        }
#undef P12_ADD8
#undef P12_LOAD
    }
#undef IN
#undef GRID_BAR
}

typedef void (*kern_t)(Args);
template <int P> static void get_kerns(kern_t* k) { k[P] = mk_fwd<(1 << P)>; if constexpr (P > 0) get_kerns<P - 1>(k); }
extern "C" void kernel_launch(void* const* d_in, const int* in_sizes, int n_in, void* d_out, int out_size, void* d_ws, size_t ws_size, hipStream_t stream) {
    static int grid = 0; static kern_t kerns[NPHASE + 1];
    if (grid == 0) {
        if (n_in != 30 || in_sizes[0] != T * D || out_size != T * D || ws_size < WS_END) { fprintf(stderr, "kernel_launch: unexpected shapes / workspace (n_in %d, ws %zu)\n", n_in, ws_size); grid = -1; return; }
        int dev = 0, cus = 0, per_cu = 0;
        if (hipGetDevice(&dev) != hipSuccess || hipDeviceGetAttribute(&cus, hipDeviceAttributeMultiprocessorCount, dev) != hipSuccess) { grid = -1; return; }
#ifdef ONLY_PH
        kerns[ONLY_PH] = mk_fwd<(1 << ONLY_PH)>;
#else
        if constexpr (MK_N_LAUNCHES == 1) kerns[NPHASE] = mk_fwd<(1 << NPHASE) - 1>; else get_kerns<NPHASE - 1>(kerns);
#endif
        for (int p = 0; p <= NPHASE; ++p) if (kerns[p]) {
            if (hipFuncSetAttribute((const void*)kerns[p], hipFuncAttributeMaxDynamicSharedMemorySize, LDS_BYTES) != hipSuccess) { fprintf(stderr, "kernel_launch: hipFuncSetAttribute failed\n"); grid = -1; return; }
            if (hipOccupancyMaxActiveBlocksPerMultiprocessor(&per_cu, (const void*)kerns[p], NTHREADS, LDS_BYTES) != hipSuccess || per_cu < 1) { fprintf(stderr, "kernel_launch: occupancy query reports %d for kernel %d\n", per_cu, p); } }
        (void)hipGetLastError();
        grid = cus;
    }
    if (grid < 0) return;
    (void)hipMemsetAsync((char*)d_ws + WS_CTL, 0, CTL_ZERO_BYTES, stream);
    Args a{};
    for (int i = 0; i < 30; ++i) a.in[i] = (const float*)d_in[i];
    a.out = (float*)d_out; a.ws = (unsigned char*)d_ws;
    if (MK_N_LAUNCHES == 1) { a.ph_lo = 0; a.ph_hi = NPHASE; hipLaunchKernelGGL(kerns[NPHASE], dim3(grid), dim3(NTHREADS), LDS_BYTES, stream, a); }
    else for (int p = 0; p < NPHASE; ++p) { a.ph_lo = p; a.ph_hi = p + 1; hipLaunchKernelGGL(kerns[p], dim3(grid), dim3(NTHREADS), LDS_BYTES, stream, a); }
}
```

```cpp
#include <hip/hip_runtime.h>
#include <cstdio>
#include <cstdint>

#ifndef MK_N_LAUNCHES
#define MK_N_LAUNCHES 1
#endif

#define LAS __attribute__((address_space(3)))
#define GAS __attribute__((address_space(1)))
typedef unsigned short bf16_t;
typedef short bf16x8 __attribute__((ext_vector_type(8)));
typedef float f32x4 __attribute__((ext_vector_type(4)));
typedef float f32x2 __attribute__((ext_vector_type(2)));
typedef float f32x16 __attribute__((ext_vector_type(16)));
typedef unsigned u32x4 __attribute__((ext_vector_type(4)));
typedef unsigned u32x2 __attribute__((ext_vector_type(2)));
typedef short s16x4 __attribute__((ext_vector_type(4)));
typedef int i32x4 __attribute__((ext_vector_type(4)));
typedef int i32x8 __attribute__((ext_vector_type(8)));
typedef GAS unsigned gu32;

constexpr int T = 32768, D = 1024, INW = 3584, NE = 32;
constexpr int AS5_LD = 384;
constexpr float NORM_EPS = 1e-5f;
constexpr int NWAVES = 8, NTHREADS = 512;
constexpr int NPHASE = 13;

constexpr size_t MiB = 1u << 20, KiB = 1024;
constexpr size_t WS_CTL = 0, CTL_ZERO_BYTES = 64 * KiB;
constexpr size_t WS_RS1 = 1 * MiB, WS_RS2 = WS_RS1 + 128 * KiB;
constexpr size_t WS_TOPE = WS_RS2 + 128 * KiB, WS_TOPG = WS_TOPE + 512 * KiB, WS_SPOS = WS_TOPG + 512 * KiB, WS_SROW = WS_SPOS + 512 * KiB;
constexpr int NROWS_CAP = 131072 + 512;
constexpr size_t WS_RTOK = WS_SROW + 512 * KiB, WS_RGATE = WS_RTOK + 640 * KiB, WS_RRS = WS_RGATE + 640 * KiB;
constexpr size_t WS_LAM = WS_RRS + 640 * KiB;
constexpr size_t WS_TRASH = WS_LAM + 64 * KiB;
constexpr size_t WS_BG = WS_TRASH + 128 * KiB, WS_BU = WS_BG + 128 * KiB, WS_BD = WS_BU + 128 * KiB, WS_BGLU = WS_BD + 128 * KiB;
constexpr size_t WS_G2S = WS_BGLU + 4 * KiB;
constexpr size_t WS_WRIMG = WS_G2S + 8 * KiB;
static_assert(WS_WRIMG + 132096 <= 8 * MiB, "tables");
constexpr size_t WS_WDT = 8 * MiB;
constexpr size_t WS_H1F8 = 40 * MiB;
constexpr size_t WS_H1B = 72 * MiB;
constexpr size_t WS_Y = 136 * MiB;
constexpr size_t WS_W1T = 136 * MiB;
constexpr size_t WS_AS5 = 264 * MiB;
constexpr size_t WS_U = 312 * MiB, WS_V = 344 * MiB;
constexpr size_t WS_WINT = 376 * MiB, WS_W1S = 383 * MiB, WS_MT = 387 * MiB;
constexpr size_t WS_HWS = 393 * MiB;
constexpr size_t WS_SST = 393 * MiB, WS_YAB = 425 * MiB, WS_MRG = 200 * MiB, WS_Z = 489 * MiB;
constexpr size_t WS_RT2 = 376 * MiB, WS_RG2 = 380 * MiB, WS_RR2 = 384 * MiB;
constexpr size_t WS_SMALL = 522 * MiB;
constexpr size_t WS_WGLUT = WS_SMALL, WS_WAT = WS_WGLUT + 512 * KiB, WS_WBT = WS_WAT + 1 * MiB, WS_WOT = WS_WBT + 1 * MiB, WS_WM = WS_WOT + 2 * MiB;
constexpr size_t WS_WINT8 = 527 * MiB;
constexpr size_t WS_END = 529 * MiB;
static_assert(WS_WM + 128 * KiB <= WS_END && WS_YAB + 64 * MiB <= WS_SMALL && WS_MRG + 64 * MiB <= WS_V && WS_Y + 257 * MiB <= WS_HWS && WS_MT + 6 * MiB <= WS_HWS, "ws map");
constexpr int HSPLIT = 65536;
constexpr int CW_BAR = 4096, CW_CNT = 8192;

constexpr int LDS_BYTES = 163840;
constexpr int LDS_X = 131072;
constexpr int LDS_AUX = LDS_X + 16384;
constexpr int LDS_MISC = LDS_BYTES - 256;

#define LDS_WAIT() asm volatile("s_waitcnt lgkmcnt(0)" ::: "memory")
#define VM_WAIT() asm volatile("s_waitcnt vmcnt(0)" ::: "memory")
#define RLX_AGENT __ATOMIC_RELAXED, __HIP_MEMORY_SCOPE_AGENT
__device__ __forceinline__ unsigned cvt_pk_bf16(float lo, float hi) { unsigned r; asm volatile("v_cvt_pk_bf16_f32 %0, %1, %2" : "=v"(r) : "v"(lo), "v"(hi)); return r; }
__device__ __forceinline__ float bflo(unsigned w) { return __builtin_bit_cast(float, w << 16); }
__device__ __forceinline__ float bfhi(unsigned w) { return __builtin_bit_cast(float, w & 0xffff0000u); }
__device__ __forceinline__ f32x4 exp2_v(f32x4 x) { return (f32x4){__builtin_amdgcn_exp2f(x[0]), __builtin_amdgcn_exp2f(x[1]), __builtin_amdgcn_exp2f(x[2]), __builtin_amdgcn_exp2f(x[3])}; }
__device__ __forceinline__ f32x4 rcp_v(f32x4 x) { return (f32x4){__builtin_amdgcn_rcpf(x[0]), __builtin_amdgcn_rcpf(x[1]), __builtin_amdgcn_rcpf(x[2]), __builtin_amdgcn_rcpf(x[3])}; }
__device__ __forceinline__ f32x4 sigmoid_v(f32x4 x) { return rcp_v(exp2_v(x * -1.4426950408889634f) + 1.0f); }
__device__ __forceinline__ f32x4 gelu_v(f32x4 x) { const f32x4 u = x * (x * x * (0.044715f * 2.302208198f) + 2.302208198f); return x * rcp_v(exp2_v(-u) + 1.0f); }
__device__ __forceinline__ float wave_sum(float v) {
#pragma unroll
    for (int o = 1; o < 64; o <<= 1) v += __shfl_xor(v, o);
    return v;
}
__device__ __forceinline__ u32x2 pack8_f8(f32x4 a, f32x4 b) {
    int lo = __builtin_amdgcn_cvt_pk_fp8_f32(a[0], a[1], 0, false); lo = __builtin_amdgcn_cvt_pk_fp8_f32(a[2], a[3], lo, true);
    int hi = __builtin_amdgcn_cvt_pk_fp8_f32(b[0], b[1], 0, false); hi = __builtin_amdgcn_cvt_pk_fp8_f32(b[2], b[3], hi, true);
    return (u32x2){(unsigned)lo, (unsigned)hi}; }
__device__ __forceinline__ u32x4 pack8(f32x4 a, f32x4 b) { u32x4 w; w.x = cvt_pk_bf16(a[0], a[1]); w.y = cvt_pk_bf16(a[2], a[3]); w.z = cvt_pk_bf16(b[0], b[1]); w.w = cvt_pk_bf16(b[2], b[3]); return w; }
__device__ __forceinline__ void unpack8(u32x4 w, f32x4& a, f32x4& b) { a = (f32x4){bflo(w.x), bfhi(w.x), bflo(w.y), bfhi(w.y)}; b = (f32x4){bflo(w.z), bfhi(w.z), bflo(w.w), bfhi(w.w)}; }

#define XB_TMO      128
#define XB_XCNT(j)  (256  + 64 * (j))
#define XB_XSUB(j)  (1280 + 64 * (j))
#define XB_XGEN(j)  (2304 + 64 * (j))
#define XB_TOP      3328
#define XB_TOPGEN   3392
#define XCD_BAR_WORDS 3456
#define XB_SPIN_CAP (1u << 20)
__device__ __forceinline__ unsigned xb_ld(unsigned* p)              { return __hip_atomic_load(p, __ATOMIC_RELAXED, __HIP_MEMORY_SCOPE_AGENT); }
__device__ __forceinline__ unsigned xb_add(unsigned* p, unsigned v) { return __hip_atomic_fetch_add(p, v, __ATOMIC_RELAXED, __HIP_MEMORY_SCOPE_AGENT); }
__device__ __forceinline__ unsigned xb_xcc_id() { return (unsigned)__builtin_amdgcn_s_getreg((3 << 11) | 20) & 0xFu; }
#define XB_SPIN(cond, bar) do { unsigned _sp = 0; while (cond) { __builtin_amdgcn_s_sleep(1); \
    if ((++_sp & 255u) == 0u) { if (xb_ld(&(bar)[XB_TMO])) break; if (_sp > XB_SPIN_CAP) { atomicAdd(&(bar)[XB_TMO], 1u); break; } } } } while (0)
struct XcdBarrier { unsigned* bar; unsigned x; volatile LAS unsigned* st; };
__device__ __forceinline__ XcdBarrier xcd_barrier_post(unsigned* bar, volatile LAS unsigned* st) {
    XcdBarrier b; b.bar = bar; b.x = xb_xcc_id(); b.st = st;
    if (threadIdx.x == 0) st[3] = xb_add(&bar[XB_XCNT(b.x)], 1u);
    return b;
}
__device__ __forceinline__ u32x4 pair16_f8(u32x2 a, u32x2 b) {
    const auto s0 = __builtin_amdgcn_permlane16_swap(a.x, b.x, false, false), s1 = __builtin_amdgcn_permlane16_swap(a.y, b.y, false, false);
    return (u32x4){s0[0], s1[0], s0[1], s1[1]};
}
__device__ __forceinline__ void xcd_barrier_complete(unsigned* bar, unsigned x, unsigned& nloc, unsigned& nx, unsigned& uniform) {
    const unsigned G = gridDim.x * gridDim.y * gridDim.z;
    unsigned sum, cnt, mine, sp = 0u;
    for (;;) {
        sum = 0u; cnt = 0u; mine = 0u;
#pragma unroll
        for (unsigned j = 0; j < 16; ++j) { const unsigned c = xb_ld(&bar[XB_XCNT(j)]); sum += c; cnt += (c > 0u) ? 1u : 0u; mine = (j == x) ? c : mine; }
        if (sum == G) break;
        __builtin_amdgcn_s_sleep(1);
        if ((++sp & 255u) == 0u) { if (xb_ld(&bar[XB_TMO])) break; if (sp > XB_SPIN_CAP) { atomicAdd(&bar[XB_TMO], 1u); break; } }
    }
    nloc = mine > 0u ? mine : 1u; nx = cnt > 0u ? cnt : 1u;
    unsigned u = (sum == G && G == 256u) ? 1u : 0u;
#pragma unroll
    for (unsigned j = 0; j < 16; ++j) { const unsigned c = xb_ld(&bar[XB_XCNT(j)]); if (c != (j < 8u ? G / 8u : 0u)) u = 0u; }
    uniform = u;
}
__device__ __forceinline__ void xcd_barrier(const XcdBarrier& b) {
    asm volatile("s_waitcnt vmcnt(0)" ::: "memory");
    __syncthreads();
    if (threadIdx.x == 0) {
        unsigned* bar = b.bar;
        __builtin_amdgcn_s_waitcnt(0);
        unsigned nloc = b.st[0], nx = b.st[1];
        if (nloc == 0u) { unsigned uni = 0u; xcd_barrier_complete(bar, b.x, nloc, nx, uni); b.st[0] = nloc; b.st[1] = nx; b.st[2] = uni; }
        const unsigned old = xb_add(&bar[XB_XSUB(b.x)], 1u);
        const unsigned gen = old / nloc;
        if (old + 1u == (gen + 1u) * nloc) {
            __builtin_amdgcn_fence(__ATOMIC_RELEASE, "agent");
            asm volatile("s_waitcnt vmcnt(0)" ::: "memory");
            const unsigned og = xb_add(&bar[XB_TOP], 1u);
            const unsigned tg = og / nx;
            if (og + 1u == (tg + 1u) * nx) xb_add(&bar[XB_TOPGEN], 1u);
            else XB_SPIN(xb_ld(&bar[XB_TOPGEN]) == tg, bar);
            xb_add(&bar[XB_XGEN(b.x)], 1u);
            __builtin_amdgcn_fence(__ATOMIC_ACQUIRE, "agent");
            asm volatile("s_waitcnt vmcnt(0)" ::: "memory");
        } else {
            XB_SPIN(xb_ld(&bar[XB_XGEN(b.x)]) == gen, bar);
            __builtin_amdgcn_fence(__ATOMIC_ACQUIRE, "agent");
            asm volatile("s_waitcnt vmcnt(0)" ::: "memory");
        }
    }
    __syncthreads();
}

#define XL_CNT(j) (3456 + 64 * (j))
__device__ __forceinline__ void xcd_local_barrier(unsigned* bar, unsigned x, unsigned target) {
    asm volatile("s_waitcnt vmcnt(0)" ::: "memory");
    __syncthreads();
    if (threadIdx.x == 0) {
        __builtin_amdgcn_s_waitcnt(0);
        (void)xb_add(&bar[XL_CNT(x)], 1u);
        XB_SPIN(xb_ld(&bar[XL_CNT(x)]) < target, bar);
        __builtin_amdgcn_fence(__ATOMIC_ACQUIRE, "agent");
        asm volatile("s_waitcnt vmcnt(0)" ::: "memory");
    }
    __syncthreads();
}

namespace pg8 {
constexpr int BM = 256, BK = 64, HALF = 128, HTB = HALF * BK * 2, STAGE_BYTES = 8 * HTB, NXCD = 8, WGM = 8;
__host__ __device__ __forceinline__ int lds_byte(int r, int c) { const int st = (r >> 4) * 2 + (c >> 5), rr = r & 15, cc = c & 31, ob = rr * 64 + cc * 2; return st * 1024 + (ob ^ (((ob >> 9) & 1) << 5)); }
__host__ __device__ __forceinline__ void stage_rc(int b, int& R, int& C) { const int st = b / 1024, sb = b % 1024, swz = sb ^ (((sb >> 9) & 1) << 5); R = (st >> 1) * 16 + swz / 64; C = (st & 1) * 32 + (swz % 64) / 2; }
__host__ __device__ __forceinline__ int perm32(int rho) { const int n = rho >> 4, i = rho & 15; return 8 * (i >> 2) + 4 * n + (i & 3); }

struct Unit { unsigned a, b; int pm, pn, x0, x1; };
__device__ __forceinline__ void tile_order(int L, int nM, int nN, int& pm, int& pn) {
    const int nwg = nM * nN; int wgid = L; { const int q = nwg / NXCD, r = nwg % NXCD, xcd = wgid % NXCD, off = wgid / NXCD; wgid = (xcd < r ? xcd * (q + 1) : r * (q + 1) + (xcd - r) * q) + off; }
    const int nig = WGM * nN, gid = wgid / nig, fm = gid * WGM, gsz = (nM - fm) < WGM ? (nM - fm) : WGM;
    pm = fm + ((wgid % nig) % gsz); pn = (wgid % nig) / gsz;
}

struct NoHook { static constexpr bool ON = false; __device__ __forceinline__ void operator()(int) const {} };
template <class Epi, class Sched, class Hook = NoHook>
__device__ __forceinline__ void gemm_phase(LAS unsigned char* lds, const void* wsbase, const Sched& S, const Epi& E, const Hook& H = Hook{}) {
    const __amdgpu_buffer_rsrc_t rsrc = __builtin_amdgcn_make_buffer_rsrc((void*)wsbase, 0, 0x7fffffff, 0x00020000);
    constexpr bool GATHER = Sched::GATHER, F8 = Sched::F8;
    int tid_ = threadIdx.x; asm volatile("" : "+v"(tid_));
    const int tid = tid_, wid = __builtin_amdgcn_readfirstlane(tid >> 6), lane = tid & 63, wr = wid >> 2, wc = wid & 3, fr = lane & 15, fq = lane >> 4;
    const int nt = S.nt; const unsigned K2 = S.K2, hstepB = 128u * K2, hstepA = S.hstepA;
    unsigned voffA[2], voffB[2];
#pragma unroll
    for (int i = 0; i < 2; ++i) { int R, C; stage_rc(tid * 16 + i * 8192, R, C); const int Rb = (R & ~31) + perm32(R & 31);
        voffA[i] = (unsigned)R * S.lda2 + (unsigned)C * 2u; voffB[i] = (unsigned)Rb * K2 + (unsigned)C * 2u; }
    const unsigned ldsw = (unsigned)wid * 1024u;
    const int aoff = lds_byte(wr * 64 + fr, fq * 8), boff = lds_byte(wc * 32 + fr, fq * 8);
#define PG8_SA(b, h) (((b) * 2 + (h)) * HTB)
#define PG8_SB(b, h) ((4 + (b) * 2 + (h)) * HTB)
#define PG8_GLDS(vo_, so_, lo) __builtin_amdgcn_raw_ptr_buffer_load_lds(rsrc, (LAS void*)(lds + (lo)), 16, (int)(vo_), (int)(so_), 0, 0)
#define PG8_STAGE_B(bufoff, gbase) do { _Pragma("unroll") for (int _i = 0; _i < 2; ++_i) PG8_GLDS(voffB[_i], (gbase), (bufoff) + ldsw + _i * 8192); } while (0)
#define PG8_STAGE_A(bufoff, gbase, h, VO) do { _Pragma("unroll") for (int _i = 0; _i < 2; ++_i) { \
        if constexpr (GATHER) PG8_GLDS(VO[h][_i], (gbase), (bufoff) + ldsw + _i * 8192); \
        else PG8_GLDS(voffA[_i], (gbase) + (h) * hstepA, (bufoff) + ldsw + _i * 8192); } } while (0)
#define PG8_LDA8(dst, b, h) do { _Pragma("unroll") for (int m = 0; m < 4; ++m) { const i32x4 lo_ = *(const LAS i32x4*)(lds + PG8_SA(b, h) + aoff + m * 2048), hi_ = *(const LAS i32x4*)(lds + PG8_SA(b, h) + aoff + m * 2048 + 1024); dst[m] = __builtin_shufflevector(lo_, hi_, 0, 1, 2, 3, 4, 5, 6, 7); } } while (0)
#define PG8_LDB8(dst, b, h) do { _Pragma("unroll") for (int n = 0; n < 2; ++n) { const i32x4 lo_ = *(const LAS i32x4*)(lds + PG8_SB(b, h) + boff + n * 2048), hi_ = *(const LAS i32x4*)(lds + PG8_SB(b, h) + boff + n * 2048 + 1024); dst[n] = __builtin_shufflevector(lo_, hi_, 0, 1, 2, 3, 4, 5, 6, 7); } } while (0)
#define PG8_LDA_(dst, dst8, b, h) do { if constexpr (F8) PG8_LDA8(dst8, b, h); else PG8_LDA(dst, b, h); } while (0)
#define PG8_LDB_(dst, dst8, b, h) do { if constexpr (F8) PG8_LDB8(dst8, b, h); else PG8_LDB(dst, b, h); } while (0)
#define PG8_LDA(dst, b, h) do { _Pragma("unroll") for (int m = 0; m < 4; ++m) _Pragma("unroll") for (int k = 0; k < 2; ++k) dst[m][k] = *(const LAS bf16x8*)(lds + PG8_SA(b, h) + aoff + m * 2048 + k * 1024); } while (0)
#define PG8_LDB(dst, b, h) do { _Pragma("unroll") for (int n = 0; n < 2; ++n) _Pragma("unroll") for (int k = 0; k < 2; ++k) dst[n][k] = *(const LAS bf16x8*)(lds + PG8_SB(b, h) + boff + n * 2048 + k * 1024); } while (0)
#define PG8_MMA(ai, bj, At, Bt) do { __builtin_amdgcn_s_setprio(1); _Pragma("unroll") for (int m = 0; m < 4; ++m) _Pragma("unroll") for (int n = 0; n < 2; ++n) { \
        if constexpr (F8) asm volatile("s_nop 1\n\tv_mfma_scale_f32_16x16x128_f8f6f4 %0, %1, %2, %0, %3, %3 op_sel_hi:[0,0,0]" : "+v"(acc[ai][bj][m][n]) : "v"(Bt##8[n]), "v"(At##8[m]), "v"(f8scale));   \
        else { _Pragma("unroll") for (int k = 0; k < 2; ++k) asm volatile("s_nop 1\n\tv_mfma_f32_16x16x32_bf16 %0, %1, %2, %0" : "+v"(acc[ai][bj][m][n]) : "v"(Bt[n][k]), "v"(At[m][k])); } }   \
        __builtin_amdgcn_s_setprio(0); } while (0)
#define PG8_WAIT_V(n) asm volatile("s_waitcnt vmcnt(" #n ")" ::: "memory")
#define PG8_WAIT_L(n) asm volatile("s_waitcnt lgkmcnt(" #n ")" ::: "memory")
#define PG8_WAIT_VR(tt) asm volatile("s_cmp_eq_u32 %0, 0\n\ts_cbranch_scc0 .Lwv8_%=\n\ts_waitcnt vmcnt(%1)\n\ts_branch .Lwvd_%=\n.Lwv8_%=:\n\ts_waitcnt vmcnt(8)\n.Lwvd_%=:" :: "s"(tt), "i"((8 + Epi::NST) > 63 ? 63 : (8 + Epi::NST)) : "memory", "scc")
#define PG8_BAR __builtin_amdgcn_s_barrier()
#define PG8_SCHED __builtin_amdgcn_sched_barrier(0)
    Unit cur, nxt; int ui = 0;
    if (!S.next(0, cur)) return;
    unsigned cvo[2][2];
    if constexpr (GATHER) S.aoffs(cur, cvo); else { cvo[0][0] = cvo[0][1] = cvo[1][0] = cvo[1][1] = 0u; }
    f32x4 acc[2][2][4][2];
#pragma unroll
    for (int a = 0; a < 2; ++a)
#pragma unroll
        for (int b = 0; b < 2; ++b)
#pragma unroll
            for (int m = 0; m < 4; ++m)
#pragma unroll
                for (int n = 0; n < 2; ++n) acc[a][b][m][n] = (f32x4){0.f, 0.f, 0.f, 0.f};
    const int f8scale = 0x7f7f7f7f;
    bf16x8 At[4][2], B0[2][2], B1[2][2]; i32x8 At8[4], B08[2], B18[2];
    unsigned cA = cur.a, cB = cur.b;
    PG8_STAGE_B(PG8_SB(0, 0), cB); PG8_STAGE_B(PG8_SB(0, 1), cB + hstepB); PG8_STAGE_A(PG8_SA(0, 0), cA, 0, cvo); PG8_STAGE_A(PG8_SA(0, 1), cA, 1, cvo);
    PG8_STAGE_B(PG8_SB(1, 0), cB + 128); PG8_STAGE_B(PG8_SB(1, 1), cB + hstepB + 128);
    if (wr == 1) PG8_BAR;
    PG8_WAIT_V(0); PG8_BAR; PG8_BAR;
    for (;;) {
        const bool has_next = S.next(ui + 1, nxt);
        const unsigned nA = has_next ? nxt.a : cA, nB = has_next ? nxt.b : cB;
        for (int t = 0; t < nt; t += 2) {
            const bool last = (t == nt - 2);
            if constexpr (Epi::MID) { if (t == Epi::TMID) { asm volatile("s_nop 15\n\ts_nop 15" ::: "memory"); E.mid(acc, cur, wr, wc, fr, fq); PG8_SCHED; } }
            const unsigned a1 = cA + (unsigned)(t + 1) * 128u;
            const unsigned a2 = last ? nA : cA + (unsigned)(t + 2) * 128u, b2 = last ? nB : cB + (unsigned)(t + 2) * 128u;
            const unsigned b3 = b2 + 128u;
            PG8_LDB_(B0, B08, 0, 0); PG8_LDB_(B1, B18, 0, 1); PG8_SCHED; PG8_LDA_(At, At8, 0, 0); PG8_STAGE_A(PG8_SA(1, 0), a1, 0, cvo); PG8_STAGE_A(PG8_SA(1, 1), a1, 1, cvo);
            if constexpr (Epi::NAUX > 0) { if (t == 0 && wid < Epi::NAUX) PG8_GLDS(E.auxoff(cur, wid, lane), 0u, LDS_AUX + (ui & 1) * 4096 + wid * 1024); }
            if constexpr (GATHER) { if (t == 0 && wid == 2 && has_next) PG8_GLDS(S.rtkoff(nxt, lane), 0u, LDS_AUX + (ui & 1) * 4096 + 2048); }
            PG8_WAIT_VR(t); PG8_WAIT_L(0); PG8_BAR; PG8_MMA(0, 0, At, B0); PG8_MMA(0, 1, At, B1); PG8_BAR; PG8_SCHED;
            if constexpr (GATHER) { if (last && has_next) S.aoffs_lds(nxt, (const LAS int*)(lds + LDS_AUX + (ui & 1) * 4096 + 2048), cvo); }
            PG8_LDA_(At, At8, 0, 1); PG8_STAGE_B(PG8_SB(0, 0), b2); PG8_STAGE_B(PG8_SB(0, 1), b2 + hstepB);
            PG8_WAIT_V(6); PG8_WAIT_L(0); PG8_BAR; PG8_MMA(1, 0, At, B0); PG8_MMA(1, 1, At, B1); PG8_BAR; PG8_SCHED;
            PG8_LDB_(B0, B08, 1, 0); PG8_LDB_(B1, B18, 1, 1); PG8_SCHED; PG8_LDA_(At, At8, 1, 0); PG8_STAGE_A(PG8_SA(0, 0), a2, 0, cvo); PG8_STAGE_A(PG8_SA(0, 1), a2, 1, cvo);
            PG8_WAIT_V(8); PG8_WAIT_L(0); PG8_BAR; PG8_MMA(0, 0, At, B0); PG8_MMA(0, 1, At, B1); PG8_BAR; PG8_SCHED;
            PG8_LDA_(At, At8, 1, 1); PG8_STAGE_B(PG8_SB(1, 0), b3); PG8_STAGE_B(PG8_SB(1, 1), b3 + hstepB);
            PG8_WAIT_V(6); PG8_WAIT_L(0); PG8_BAR; PG8_MMA(1, 0, At, B0); PG8_MMA(1, 1, At, B1); PG8_BAR; PG8_SCHED;
        }
        if (wr == 0) PG8_BAR;
        asm volatile("s_nop 15\n\ts_nop 15" ::: "memory");
        E(acc, cur, wr, wc, fr, fq, lds + LDS_AUX + (ui & 1) * 4096);
        PG8_SCHED;
        if constexpr (Hook::ON) { H(ui); PG8_SCHED; }
        if (!has_next) break;
#pragma unroll
        for (int a = 0; a < 2; ++a)
#pragma unroll
            for (int b = 0; b < 2; ++b)
#pragma unroll
                for (int m = 0; m < 4; ++m)
#pragma unroll
                    for (int n = 0; n < 2; ++n) acc[a][b][m][n] = (f32x4){0.f, 0.f, 0.f, 0.f};
        cur = nxt; cA = nA; cB = nB; ++ui;
        if (wr == 1) PG8_BAR;
    }
    PG8_WAIT_V(0);
    PG8_BAR;
#undef PG8_SA
#undef PG8_SB
#undef PG8_GLDS
#undef PG8_STAGE_A
#undef PG8_STAGE_B
#undef PG8_LDA
#undef PG8_LDB
#undef PG8_MMA
#undef PG8_LDA8
#undef PG8_LDB8
#undef PG8_LDA_
#undef PG8_LDB_
#undef PG8_WAIT_V
#undef PG8_WAIT_L
#undef PG8_WAIT_VR
#undef PG8_BAR
#undef PG8_SCHED
}

template <bool F8_>
struct DenseSchedT {
    static constexpr bool GATHER = false, F8 = F8_;
    unsigned A, Bt; unsigned lda2, K2, hstepA; int nt, nM, nN, nwg, G, c, pm0;
    __device__ __forceinline__ void init(size_t A_, size_t Bt_, int M, int N, int K, int lda, int G_, int c_) {
        constexpr unsigned esz = F8_ ? 1u : 2u; pm0 = 0;
        A = (unsigned)A_; Bt = (unsigned)Bt_; lda2 = (unsigned)lda * esz; K2 = (unsigned)K * esz; hstepA = 128u * lda2; nt = (int)(K2 / 128u); nM = M / 256; nN = N / 256; nwg = nM * nN; G = G_; c = c_; }
    __device__ __forceinline__ bool next(int i, Unit& u) const {
        const long L = (long)i * G + c; if (L >= nwg) return false;
        tile_order((int)L, nM, nN, u.pm, u.pn); u.pm += pm0;
        u.a = A + (unsigned)u.pm * 256u * lda2; u.b = Bt + (unsigned)u.pn * 256u * K2; u.x0 = 0; u.x1 = 0; return true; }
    __device__ __forceinline__ void aoffs(const Unit&, unsigned (&)[2][2]) const {}
};
typedef DenseSchedT<false> DenseSched;
struct S5Sched {
    static constexpr bool GATHER = false, F8 = false;
    unsigned A, Bt; unsigned lda2, K2, hstepA; int nt, id;
    __device__ __forceinline__ void init(size_t A_, size_t Bt_, int K, int id_) { A = (unsigned)A_; Bt = (unsigned)Bt_; lda2 = AS5_LD * 2; K2 = (unsigned)K * 2u; hstepA = 128u * lda2; nt = K / 64; id = id_; }
    __device__ __forceinline__ bool next(int i, Unit& u) const {
        if (i > 0 || id >= 256) return false;
        const int g = id >> 3; u.pm = id & 7; u.pn = 0; u.x0 = g; u.x1 = 0;
        u.a = A + ((unsigned)g * 2048u + (unsigned)u.pm * 256u) * lda2; u.b = Bt + (unsigned)g * 256u * K2; return true; }
    __device__ __forceinline__ void aoffs(const Unit&, unsigned (&)[2][2]) const {}
};
struct MoeSched1 {
    static constexpr bool GATHER = true, F8 = true;
    unsigned A, Bt; const int* rtk; const LAS int* tt; unsigned lda2, K2, hstepA; int nt, ntiles, G, vc;
    __device__ __forceinline__ bool next(int i, Unit& u) const {
        const int L = i * G + vc; const int tile = L >> 3; if (tile >= ntiles) return false;
        const int w0 = __builtin_amdgcn_readfirstlane(tt[2 * tile]), row0 = __builtin_amdgcn_readfirstlane(tt[2 * tile + 1]);
        const int e = w0 & 255; u.pm = e * T + (row0 - __builtin_amdgcn_readfirstlane(tt[1432 + e])); u.pn = L & 7; u.x0 = row0; u.x1 = w0;
        u.a = A; u.b = Bt + ((unsigned)e * 2048u + (unsigned)u.pn * 256u) * K2; return true; }
    __device__ __forceinline__ unsigned rtkoff(const Unit& u, int lane) const { return (unsigned)WS_RT2 + (unsigned)u.pm * 4u + (unsigned)lane * 16u; }
    __device__ __forceinline__ void aoffs_lds(const Unit& u, const LAS int* tl, unsigned (&vo)[2][2]) const {
        const int nrows = u.x1 >> 8; int Rr[2], Cc[2];
        { int t_ = threadIdx.x; asm volatile("" : "+v"(t_));
#pragma unroll
        for (int i = 0; i < 2; ++i) stage_rc(t_ * 16 + i * 8192, Rr[i], Cc[i]); }
#pragma unroll
        for (int h = 0; h < 2; ++h)
#pragma unroll
            for (int i = 0; i < 2; ++i) { const int rl = h * 128 + Rr[i]; const int tok = rl < nrows ? tl[rl] : 0; vo[h][i] = (unsigned)tok * 1024u + (unsigned)Cc[i] * 2u; }
    }
    __device__ __forceinline__ void aoffs(const Unit& u, unsigned (&vo)[2][2]) const {
        const int nrows = u.x1 >> 8; int Rr[2], Cc[2];
        { int t_ = threadIdx.x; asm volatile("" : "+v"(t_));
#pragma unroll
        for (int i = 0; i < 2; ++i) stage_rc(t_ * 16 + i * 8192, Rr[i], Cc[i]); }
#pragma unroll
        for (int h = 0; h < 2; ++h)
#pragma unroll
            for (int i = 0; i < 2; ++i) { const int rl = h * 128 + Rr[i]; const int tok = rl < nrows ? rtk[u.pm + rl] : 0; vo[h][i] = (unsigned)tok * 1024u + (unsigned)Cc[i] * 2u; }
    }
};
struct MoeSched2 {
    static constexpr bool GATHER = false, F8 = true;
    unsigned Ahi, Bt; const LAS int* tt; unsigned lda2, K2, hstepA; int nt, ntiles, G, vc;
    __device__ __forceinline__ bool next(int i, Unit& u) const {
        const int L = i * G + vc; const int tile = L >> 2; if (tile >= ntiles) return false;
        const int w0 = __builtin_amdgcn_readfirstlane(tt[2 * tile]), row0 = __builtin_amdgcn_readfirstlane(tt[2 * tile + 1]);
        const int e = w0 & 255; u.pm = e * T + (row0 - __builtin_amdgcn_readfirstlane(tt[1432 + e])); u.pn = L & 3; u.x0 = row0; u.x1 = w0;
        u.a = Ahi + (unsigned)row0 * 1024u; u.b = Bt + ((unsigned)e * 1024u + (unsigned)u.pn * 256u) * K2; return true; }
    __device__ __forceinline__ void aoffs(const Unit&, unsigned (&)[2][2]) const {}
};

#define EPI_ARGS const f32x4 (&acc)[2][2][4][2], const Unit& u, int wr, int wc, int fr_in, int fq_in, const LAS unsigned char* aux
#define EPI_LAUNDER int fr = fr_in, fq = fq_in; asm volatile("" : "+v"(fr), "+v"(fq));
#define INP_F8_GROUPS {0, 2}
#define INP_BF_GROUPS {1}
#define MOE_KSG 2.455467f
#define INP_NF8 2
#define INP_NBF 1
struct EpiInProj {
    static constexpr bool MID = false; static constexpr int TMID = 0; static constexpr int NAUX = 1;
    static constexpr int NST = 16;
    __device__ __forceinline__ unsigned auxoff(const Unit& u, int, int lane) const { return (unsigned)WS_RS1 + (unsigned)(u.pm * 256) * 4u + (unsigned)lane * 16u; }
    bf16_t *AS5, *U, *V; int pmap; float wsc;
    __device__ __forceinline__ void operator()(EPI_ARGS) const {
        EPI_LAUNDER
        const int row0 = u.pm * 256 + wr * 64 + fr, colw = wc * 32 + 8 * fq, pn = (pmap >> (4 * u.pn)) & 15;
        const int mode = pn < 2 ? 0 : 1;
#pragma unroll
        for (int ai = 0; ai < 2; ++ai)
#pragma unroll
            for (int m = 0; m < 4; ++m) { const int row = row0 + ai * 128 + m * 16; const float rs = ((const LAS float*)aux)[ai * 128 + wr * 64 + m * 16 + fr] * wsc;
#pragma unroll
                for (int bj = 0; bj < 2; ++bj) { const int c = pn * 256 + bj * 128 + colw; f32x4 v0 = acc[ai][bj][m][0] * rs, v1 = acc[ai][bj][m][1] * rs; bf16_t* dst;
                    if (mode == 0) { dst = AS5 + ((size_t)((c >> 4) * 2048 + (row >> 4)) * AS5_LD + (row & 15) * 16 + (c & 15)); }
                    else {
                        v0 = gelu_v(v0); v1 = gelu_v(v1);
                        dst = (pn < 4 ? U + (size_t)row * 512 + (c - 512) : V + (size_t)row * 512 + (c - 1024)); }
                    *(u32x4*)dst = pack8(v0, v1); } }
    }
};
struct EpiGates {
    static constexpr bool MID = false; static constexpr int TMID = 0; static constexpr int NAUX = 1;
    static constexpr int NST = 16;
    __device__ __forceinline__ unsigned auxoff(const Unit& u, int, int lane) const { return (unsigned)WS_RS1 + (unsigned)(u.pm * 256) * 4u + (unsigned)lane * 16u; }
    bf16_t *GA, *GB;
    __device__ __forceinline__ void operator()(EPI_ARGS) const {
        EPI_LAUNDER
        const int row0 = u.pm * 256 + wr * 64 + fr, c = u.pn * 128 + wc * 32 + 8 * fq;
#pragma unroll
        for (int ai = 0; ai < 2; ++ai)
#pragma unroll
            for (int m = 0; m < 4; ++m) { const int row = row0 + ai * 128 + m * 16; const float rs = ((const LAS float*)aux)[ai * 128 + wr * 64 + m * 16 + fr] * 0.03125f;
                f32x4 a0 = acc[ai][0][m][0] * rs, a1 = acc[ai][0][m][1] * rs, b0 = acc[ai][1][m][0] * rs, b1 = acc[ai][1][m][1] * rs;
                { const f32x4 ea = exp2_v(a0 * -1.4426950408889634f) + 1.0f, eb = exp2_v(b0 * -1.4426950408889634f) + 1.0f, ec = exp2_v(a1 * -1.4426950408889634f) + 1.0f, ed = exp2_v(b1 * -1.4426950408889634f) + 1.0f;
                  b0 = rcp_v(eb); a0 = eb * rcp_v(ea); b1 = rcp_v(ed); a1 = ed * rcp_v(ec); }
                const size_t off = (size_t)row * 1024 + c; *(u32x4*)(GA + off) = pack8(a0, a1); *(u32x4*)(GB + off) = pack8(b0, b1); }
    }
};
struct EpiInProjGates {
    static constexpr bool MID = false; static constexpr int TMID = 0; static constexpr int NAUX = 1;
    static constexpr int NST = 16;
    __device__ __forceinline__ unsigned auxoff(const Unit& u, int, int lane) const { return (unsigned)WS_RS1 + (unsigned)(u.pm * 256) * 4u + (unsigned)lane * 16u; }
    EpiInProj ip; EpiGates gt; int nf8c;
    __device__ __forceinline__ void operator()(EPI_ARGS) const {
        if (u.pn < nf8c) ip(acc, u, wr, wc, fr_in, fq_in, aux);
        else { Unit v = u; v.pn = u.pn - nf8c; gt(acc, v, wr, wc, fr_in, fq_in, aux); }
    }
};
struct EpiS5End {
    static constexpr bool MID = false; static constexpr int TMID = 0; static constexpr int NAUX = 0;
    static constexpr int NST = 16;
    float* SST;
    __device__ __forceinline__ void operator()(EPI_ARGS) const {
        EPI_LAUNDER
        const int row0 = u.pm * 256 + wr * 64 + fr, colw = wc * 32 + 8 * fq, g = u.x0;
#pragma unroll
        for (int ai = 0; ai < 2; ++ai)
#pragma unroll
            for (int m = 0; m < 4; ++m) { const int row = row0 + ai * 128 + m * 16; float* dst = SST + (size_t)row * 4096 + g * 128 + colw;
                *(f32x4*)dst = acc[ai][0][m][0]; *(f32x4*)(dst + 4) = acc[ai][0][m][1]; }
    }
};
struct EpiS5Out {
    static constexpr bool MID = false; static constexpr int TMID = 0; static constexpr int NAUX = 0;
    static constexpr int NST = 16;
    bf16_t* Z;
    __device__ __forceinline__ void operator()(EPI_ARGS) const {
        EPI_LAUNDER
        const int row0 = u.pm * 256 + wr * 64 + fr, colw = wc * 32 + 8 * fq, g = u.x0;
#pragma unroll
        for (int ai = 0; ai < 2; ++ai)
#pragma unroll
            for (int m = 0; m < 4; ++m) { const int row = row0 + ai * 128 + m * 16;
#pragma unroll
                for (int bj = 0; bj < 2; ++bj) { const int c = bj * 128 + colw; f32x4 v0 = acc[ai][bj][m][0], v1 = acc[ai][bj][m][1];
                    v0 = gelu_v(v0); v1 = gelu_v(v1);
                    *(u32x4*)(Z + ((size_t)row * 16 + (c >> 4)) * 512 + g * 16 + (c & 15)) = pack8(v0, v1); } }
    }
};
struct EpiGlu {
    static constexpr bool MID = false; static constexpr int TMID = 0; static constexpr int NAUX = 1;
    static constexpr int NST = 16;
    __device__ __forceinline__ unsigned auxoff(const Unit& u, int, int lane) const { return (unsigned)WS_BGLU + (unsigned)(u.pn * 256) * 4u + (unsigned)lane * 16u; }
    const bf16_t* Z; const float* bglu; bf16_t* YA;
    __device__ __forceinline__ void operator()(EPI_ARGS) const {
        EPI_LAUNDER
        const int row0 = u.pm * 256 + wr * 64 + fr, colw = wc * 32 + 8 * fq;
        f32x4 bb[2][2];
#pragma unroll
        for (int bj = 0; bj < 2; ++bj) { bb[bj][0] = *(const LAS f32x4*)(aux + (bj * 128 + colw) * 4); bb[bj][1] = *(const LAS f32x4*)(aux + (bj * 128 + colw) * 4 + 16); }
#pragma unroll
        for (int ai = 0; ai < 2; ++ai) { u32x4 rr[4][2];
#pragma unroll
            for (int m = 0; m < 4; ++m)
#pragma unroll
                for (int bj = 0; bj < 2; ++bj) rr[m][bj] = *(const u32x4*)(Z + (size_t)(row0 + ai * 128 + m * 16) * 512 + u.pn * 256 + bj * 128 + colw);
#pragma unroll
            for (int m = 0; m < 4; ++m)
#pragma unroll
                for (int bj = 0; bj < 2; ++bj) { const int row = row0 + ai * 128 + m * 16, c = u.pn * 256 + bj * 128 + colw;
                    f32x4 z0, z1; unpack8(rr[m][bj], z0, z1); f32x4 v0 = acc[ai][bj][m][0] + bb[bj][0], v1 = acc[ai][bj][m][1] + bb[bj][1];
                    v0 = z0 * sigmoid_v(v0); v1 = z1 * sigmoid_v(v1);
                    *(u32x4*)(YA + (size_t)row * 1024 + c) = pack8(v0, v1); }
            asm volatile("" ::: "memory"); }
    }
};
struct EpiMerge {
    static constexpr bool MID = true; static constexpr int TMID = 8; static constexpr int NAUX = 0;
    static constexpr int NST = 16;
    const bf16_t *GA, *GB; bf16_t* MRG;
    __device__ __forceinline__ void mid(f32x4 (&acc)[2][2][4][2], const Unit& u, int wr, int wc, int fr_in, int fq_in) const {
        EPI_LAUNDER
        const int row0 = u.pm * 256 + wr * 64 + fr, colw = wc * 32 + 8 * fq;
#pragma unroll
        for (int ai = 0; ai < 2; ++ai) { u32x4 rr[4][2];
#pragma unroll
            for (int m = 0; m < 4; ++m)
#pragma unroll
                for (int bj = 0; bj < 2; ++bj) rr[m][bj] = *(const u32x4*)(GA + (size_t)(row0 + ai * 128 + m * 16) * 1024 + u.pn * 256 + bj * 128 + colw);
#pragma unroll
            for (int m = 0; m < 4; ++m)
#pragma unroll
                for (int bj = 0; bj < 2; ++bj) { f32x4 a0, a1; unpack8(rr[m][bj], a0, a1); acc[ai][bj][m][0] *= a0; acc[ai][bj][m][1] *= a1; }
            asm volatile("" ::: "memory"); }
    }
    __device__ __forceinline__ void operator()(EPI_ARGS) const {
        EPI_LAUNDER
        const int row0 = u.pm * 256 + wr * 64 + fr, colw = wc * 32 + 8 * fq;
#pragma unroll
        for (int ai = 0; ai < 2; ++ai) { u32x4 rr[4][2];
#pragma unroll
            for (int m = 0; m < 4; ++m)
#pragma unroll
                for (int bj = 0; bj < 2; ++bj) rr[m][bj] = *(const u32x4*)(GB + (size_t)(row0 + ai * 128 + m * 16) * 1024 + u.pn * 256 + bj * 128 + colw);
#pragma unroll
            for (int m = 0; m < 4; ++m)
#pragma unroll
                for (int bj = 0; bj < 2; ++bj) { const size_t off = (size_t)(row0 + ai * 128 + m * 16) * 1024 + u.pn * 256 + bj * 128 + colw;
                    f32x4 b0, b1; unpack8(rr[m][bj], b0, b1); *(u32x4*)(MRG + off) = pack8(acc[ai][bj][m][0] * b0, acc[ai][bj][m][1] * b1); }
            asm volatile("" ::: "memory"); }
    }
};
struct EpiOutProj {
    static constexpr bool MID = false; static constexpr int TMID = 0; static constexpr int NAUX = 0;
    static constexpr int NST = 24;
    bf16_t* H1b; unsigned char* H1f8;
    __device__ __forceinline__ void operator()(EPI_ARGS) const {
        EPI_LAUNDER
        const int row0 = u.pm * 256 + wr * 64 + fr, colw = wc * 32 + 8 * fq;
#pragma unroll
        for (int ai = 0; ai < 2; ++ai) { u32x4 rr[4][2];
#pragma unroll
            for (int m = 0; m < 4; ++m)
#pragma unroll
                for (int bj = 0; bj < 2; ++bj) rr[m][bj] = *(const u32x4*)(H1b + (size_t)(row0 + ai * 128 + m * 16) * 1024 + u.pn * 256 + bj * 128 + colw);
#pragma unroll
            for (int mp = 0; mp < 2; ++mp)
#pragma unroll
                for (int bj = 0; bj < 2; ++bj) { u32x2 h8[2];
#pragma unroll
                    for (int q = 0; q < 2; ++q) { const int m = 2 * mp + q; const size_t off = (size_t)(row0 + ai * 128 + m * 16) * 1024 + u.pn * 256 + bj * 128 + colw;
                        f32x4 x0, x1; unpack8(rr[m][bj], x0, x1); const f32x4 v0 = acc[ai][bj][m][0] + x0, v1 = acc[ai][bj][m][1] + x1;
                        *(u32x4*)(H1b + off) = pack8(v0, v1); h8[q] = pack8_f8(v0, v1); }
                    *(u32x4*)(H1f8 + (size_t)(row0 + ai * 128 + mp * 32 + 16 * (fq & 1)) * 1024 + u.pn * 256 + bj * 128 + wc * 32 + 16 * (fq >> 1)) = pair16_f8(h8[0], h8[1]); }
            asm volatile("" ::: "memory"); }
    }
};
struct EpiMoe1 {
    static constexpr bool MID = false; static constexpr int TMID = 0; static constexpr int NAUX = 2;
    static constexpr int NST = 4;
    __device__ __forceinline__ unsigned auxoff(const Unit& u, int piece, int lane) const { const int e = u.x1 & 255;
        return piece == 0 ? (unsigned)WS_RR2 + (unsigned)u.pm * 4u + (unsigned)lane * 16u : (lane < 32 ? (unsigned)WS_BG : (unsigned)WS_BU - 512u) + (unsigned)(e * 1024 + u.pn * 128) * 4u + (unsigned)lane * 16u; }
    const float *rrs, *bgate, *bup; unsigned char *H8, *trash;
    __device__ __forceinline__ void operator()(EPI_ARGS) const {
        EPI_LAUNDER
        const int rl0 = wr * 64 + fr, colw = wc * 32 + 8 * fq, row0 = u.x0, nrows = u.x1 >> 8, e = u.x1 & 255; const int c = u.pn * 128 + wc * 32 + 16 * (fq >> 1);
        const LAS float* ab = (const LAS float*)(aux + 1024); const f32x4 bg0 = *(const LAS f32x4*)(ab + colw), bg1 = *(const LAS f32x4*)(ab + colw + 4), bu0 = *(const LAS f32x4*)(ab + 128 + colw), bu1 = *(const LAS f32x4*)(ab + 128 + colw + 4);
        unsigned char* Hb = H8 + (size_t)row0 * 1024;
#pragma unroll
        for (int ai = 0; ai < 2; ++ai)
#pragma unroll
            for (int mp = 0; mp < 2; ++mp) { u32x2 hp[2];
#pragma unroll
                for (int q = 0; q < 2; ++q) { const int m = 2 * mp + q; const float rs = ((const LAS float*)aux)[rl0 + ai * 128 + m * 16] * 0.03125f;
                    f32x4 g0 = acc[ai][0][m][0] * rs + bg0, g1 = acc[ai][0][m][1] * rs + bg1, l0 = acc[ai][1][m][0] * rs + bu0, l1 = acc[ai][1][m][1] * rs + bu1;
                    { const f32x4 gmax = (f32x4){7.0f * MOE_KSG, 7.0f * MOE_KSG, 7.0f * MOE_KSG, 7.0f * MOE_KSG}, lmin = (f32x4){-6.0f / MOE_KSG, -6.0f / MOE_KSG, -6.0f / MOE_KSG, -6.0f / MOE_KSG}, lmax = (f32x4){8.0f / MOE_KSG, 8.0f / MOE_KSG, 8.0f / MOE_KSG, 8.0f / MOE_KSG};
                      g0 = __builtin_elementwise_min(g0, gmax); g1 = __builtin_elementwise_min(g1, gmax);
                      l0 = __builtin_elementwise_min(__builtin_elementwise_max(l0, lmin), lmax); l1 = __builtin_elementwise_min(__builtin_elementwise_max(l1, lmin), lmax);
                      g0 = g0 * rcp_v(exp2_v(-g0) + 1.0f) * l0; g1 = g1 * rcp_v(exp2_v(-g1) + 1.0f) * l1; }
                    hp[q] = pack8_f8(g0, g1); }
                const int rl = rl0 + ai * 128 + mp * 32 + 16 * (fq & 1); const bool ok = rl < nrows;
                unsigned char* dst = ok ? Hb + (size_t)rl * 1024 + c : trash + (size_t)(rl & 63) * 1024 + c;
                *(u32x4*)dst = pair16_f8(hp[0], hp[1]); }
    }
};
struct EpiMoe2 {
    static constexpr bool MID = false; static constexpr int TMID = 0; static constexpr int NAUX = 2;
    static constexpr int NST = 8;
    __device__ __forceinline__ unsigned auxoff(const Unit& u, int piece, int lane) const { const int e = u.x1 & 255;
        return piece == 0 ? (unsigned)WS_RG2 + (unsigned)u.pm * 4u + (unsigned)lane * 16u : (unsigned)WS_BD + (unsigned)(e * 1024 + u.pn * 256) * 4u + (unsigned)lane * 16u; }
    const float *rgate, *bdown; unsigned char *Y, *trash;
    __device__ __forceinline__ void operator()(EPI_ARGS) const {
        EPI_LAUNDER
        const int rl0 = wr * 64 + fr, colw = wc * 32 + 8 * fq, row0 = u.x0, nrows = u.x1 >> 8, e = u.x1 & 255;
#pragma unroll
        for (int bj = 0; bj < 2; ++bj) { const int c = u.pn * 256 + bj * 128 + wc * 32 + 16 * (fq >> 1); const f32x4 b0 = *(const LAS f32x4*)(aux + 1024 + (bj * 128 + colw) * 4) * 32.0f, b1 = *(const LAS f32x4*)(aux + 1024 + (bj * 128 + colw) * 4 + 16) * 32.0f;
#pragma unroll
            for (int ai = 0; ai < 2; ++ai)
#pragma unroll
                for (int mp = 0; mp < 2; ++mp) { const int rla = rl0 + ai * 128 + mp * 32; const float ga = ((const LAS float*)aux)[rla] * 0.5f, gb = ((const LAS float*)aux)[rla + 16] * 0.5f;
                    const u32x4 o = pair16_f8(pack8_f8((acc[ai][bj][2 * mp][0] + b0) * ga, (acc[ai][bj][2 * mp][1] + b1) * ga), pack8_f8((acc[ai][bj][2 * mp + 1][0] + b0) * gb, (acc[ai][bj][2 * mp + 1][1] + b1) * gb));
                    const int rl = rla + 16 * (fq & 1); const bool ok = rl < nrows;
                    unsigned char* dst = ok ? Y + (size_t)(row0 + rl) * 1024 + c : trash + (size_t)(rl & 63) * 1024 + c;
                    *(u32x4*)dst = o; } }
    }
};
}

struct TrJob { const float* W; const float* ks; bf16_t* WT; int ldw, ldt, k0, n0, add, f8; };
__device__ __forceinline__ void transpose_load(const TrJob& j, int lane, f32x4 (&v)[8]) {
    const int kg = lane >> 3, ng = lane & 7; const float* p = j.W + (size_t)(j.k0 + 8 * kg) * j.ldw + j.n0 + 4 * ng;
#pragma unroll
    for (int e = 0; e < 8; ++e) v[e] = __builtin_nontemporal_load((const f32x4*)(p + (size_t)e * j.ldw));
}
__device__ __forceinline__ void transpose_store(const TrJob& j, int lane, f32x4 (&v)[8]) {
    const int kg = lane >> 3, ng = lane & 7;
    if (j.ks) { const f32x4 s0 = *(const f32x4*)(j.ks + j.k0 + 8 * kg), s1 = *(const f32x4*)(j.ks + j.k0 + 8 * kg + 4);
#pragma unroll
        for (int e = 0; e < 4; ++e) { v[e] *= s0[e]; v[4 + e] *= s1[e]; } }
#pragma unroll
    for (int c = 0; c < 4; ++c) { const int n = j.n0 + 4 * ng + c; const int row = j.add < 0 ? n : ((n >> 7) * 256 + (n & 127) + j.add);
        if (j.f8) { *(u32x2*)((unsigned char*)j.WT + (size_t)row * j.ldt + j.k0 + 8 * kg) = pack8_f8((f32x4){v[0][c], v[1][c], v[2][c], v[3][c]} * 32.0f, (f32x4){v[4][c], v[5][c], v[6][c], v[7][c]} * 32.0f); }
        else { u32x4 o; o.x = cvt_pk_bf16(v[0][c], v[1][c]); o.y = cvt_pk_bf16(v[2][c], v[3][c]); o.z = cvt_pk_bf16(v[4][c], v[5][c]); o.w = cvt_pk_bf16(v[6][c], v[7][c]);
            *(u32x4*)(j.WT + (size_t)row * j.ldt + j.k0 + 8 * kg) = o; } }
}

__device__ __forceinline__ void transpose8_load(const TrJob& j, int lane, f32x4 (&v)[16]) {
    const int kg = lane >> 3, ng = lane & 7; const float* p = j.W + (size_t)(j.k0 + 16 * kg) * j.ldw + j.n0 + 4 * ng;
#pragma unroll
    for (int e = 0; e < 16; ++e) v[e] = __builtin_nontemporal_load((const f32x4*)(p + (size_t)e * j.ldw));
}
__device__ __forceinline__ void transpose8_store(const TrJob& j, int lane, f32x4 (&v)[16]) {
    const int kg = lane >> 3, ng = lane & 7;
    if (j.ks) {
#pragma unroll
        for (int q = 0; q < 4; ++q) { const f32x4 s = *(const f32x4*)(j.ks + j.k0 + 16 * kg + 4 * q);
#pragma unroll
            for (int e = 0; e < 4; ++e) v[4 * q + e] *= s[e]; } }
#pragma unroll
    for (int c = 0; c < 4; ++c) { const int n = j.n0 + 4 * ng + c; const int row = j.add < 0 ? n : ((n >> 7) * 256 + (n & 127) + j.add);
        const u32x2 lo = pack8_f8((f32x4){v[0][c], v[1][c], v[2][c], v[3][c]} * 32.0f, (f32x4){v[4][c], v[5][c], v[6][c], v[7][c]} * 32.0f);
        const u32x2 hi = pack8_f8((f32x4){v[8][c], v[9][c], v[10][c], v[11][c]} * 32.0f, (f32x4){v[12][c], v[13][c], v[14][c], v[15][c]} * 32.0f);
        *(u32x4*)((unsigned char*)j.WT + (size_t)row * j.ldt + j.k0 + 16 * kg) = (u32x4){lo.x, lo.y, hi.x, hi.y}; }
}

__device__ __forceinline__ void transpose8_store_sc(const TrJob& j, int lane, f32x4 (&v)[16], const f32x4 (&sc)[4]) {
    const int kg = lane >> 3, ng = lane & 7;
#pragma unroll
    for (int c = 0; c < 4; ++c) { const int n = j.n0 + 4 * ng + c; const int row = j.add < 0 ? n : ((n >> 7) * 256 + (n & 127) + j.add);
        const u32x2 lo = pack8_f8((f32x4){v[0][c], v[1][c], v[2][c], v[3][c]} * sc[0], (f32x4){v[4][c], v[5][c], v[6][c], v[7][c]} * sc[1]);
        const u32x2 hi = pack8_f8((f32x4){v[8][c], v[9][c], v[10][c], v[11][c]} * sc[2], (f32x4){v[12][c], v[13][c], v[14][c], v[15][c]} * sc[3]);
        *(u32x4*)((unsigned char*)j.WT + (size_t)row * j.ldt + j.k0 + 16 * kg) = (u32x4){lo.x, lo.y, hi.x, hi.y}; }
}

struct Args { const float* in[30]; float* out; unsigned char* ws; int ph_lo, ph_hi; };
__device__ __forceinline__ const float* in_ptr_(int byte_off) { const float* p; asm volatile("s_load_dwordx2 %0, %1, %2\n\ts_waitcnt lgkmcnt(0)" : "=s"(p) : "s"(__builtin_amdgcn_kernarg_segment_ptr()), "i"(byte_off)); return p; }
#define INP(k) in_ptr_((k) * 8)


__device__ __forceinline__ void s5_build_group(const Args& args, int g, LAS unsigned char* lds, int tid) {
    const float *lam_re = INP(3), *lam_im = INP(4), *log_dt = INP(5), *b_re = INP(6), *b_im = INP(7), *c_re = INP(8), *c_im = INP(9), *d_skip = INP(10);
    LAS f32x2* pw = (LAS f32x2*)lds;
    LAS f32x2* bb = pw + 17 * 64;
    LAS f32x2* Cg = bb + 64 * 16;
    LAS float* Kt = (LAS float*)(Cg + 16 * 64);
    bf16_t* W1s = (bf16_t*)(args.ws + WS_W1S) + (size_t)g * 256 * 256;
    bf16_t* MT = (bf16_t*)(args.ws + WS_MT) + (size_t)g * 256 * 384;
    f32x2* lamtab = (f32x2*)(args.ws + WS_LAM);
    { const float dt = expf(log_dt[g]);
      for (int i = tid; i < 19 * 64; i += NTHREADS) { const int m = i >> 6, n = i & 63; const float lr = lam_re[g * 64 + n], li = lam_im[g * 64 + n];
          const float mf = m <= 16 ? (float)m : (m == 17 ? 16.0f : 512.0f); const float mag = expf(lr * dt * mf); float sn, cs; sincosf(li * dt * mf, &sn, &cs);
          if (m <= 16) pw[m * 64 + n] = (f32x2){mag * cs, mag * sn}; else lamtab[(m - 17) * 2048 + g * 64 + n] = (f32x2){mag * cs, mag * sn}; } }
    __syncthreads();
    for (int i = tid; i < 1024; i += NTHREADS) { const int n = i >> 4, q = i & 15; const float lr = lam_re[g * 64 + n], li = lam_im[g * 64 + n];
        const f32x2 lb = pw[64 + n]; const float nr = lb.x - 1.0f, ni = lb.y, den = 1.0f / (lr * lr + li * li);
        const float cr = (nr * lr + ni * li) * den, ci = (ni * lr - nr * li) * den;
        const float br = b_re[(g * 64 + n) * 16 + q], bi = b_im[(g * 64 + n) * 16 + q]; bb[n * 16 + q] = (f32x2){cr * br - ci * bi, cr * bi + ci * br}; }
    for (int i = tid; i < 1024; i += NTHREADS) Cg[i] = (f32x2){c_re[g * 1024 + i], c_im[g * 1024 + i]};
    __syncthreads();
    for (int i = tid; i < 4096; i += NTHREADS) { const int tau = i >> 8, p = (i >> 4) & 15, q = i & 15; float s = 0.f;
        for (int n = 0; n < 64; ++n) { const f32x2 c = Cg[p * 64 + n], w = pw[tau * 64 + n], b = bb[n * 16 + q];
            const float xr = c.x * w.x - c.y * w.y, xi = c.x * w.y + c.y * w.x; s += xr * b.x - xi * b.y; }
        if (tau == 0 && p == q) s += d_skip[g * 16 + p];
        Kt[i] = s; }
    __syncthreads();
    for (int i = tid; i < 256 * 48; i += NTHREADS) { const int row = i / 48, ch = i % 48, t = row >> 4, p = row & 15, k0 = ch * 8; float v[8];
        if (k0 < 256) { const int j = k0 >> 4, q0 = k0 & 15;
#pragma unroll
            for (int e = 0; e < 8; ++e) v[e] = (j <= t) ? Kt[((t - j) * 16 + p) * 16 + q0 + e] : 0.f; }
        else {
#pragma unroll
            for (int e = 0; e < 8; ++e) { const int sidx = k0 - 256 + e, n = sidx & 63; const f32x2 c = Cg[p * 64 + n], w = pw[(t + 1) * 64 + n];
                v[e] = (sidx < 64) ? (c.x * w.x - c.y * w.y) : -(c.x * w.y + c.y * w.x); } }
        u32x4 o; o.x = cvt_pk_bf16(v[0], v[1]); o.y = cvt_pk_bf16(v[2], v[3]); o.z = cvt_pk_bf16(v[4], v[5]); o.w = cvt_pk_bf16(v[6], v[7]);
        *(u32x4*)(MT + (size_t)row * 384 + k0) = o; }
    for (int i = tid; i < 256 * 32; i += NTHREADS) { const int row = i >> 5, k0 = (i & 31) * 8, j = k0 >> 4, q0 = k0 & 15; float v[8];
#pragma unroll
        for (int e = 0; e < 8; ++e) { if (row < 128) { const int n = row & 63; const f32x2 w = pw[(15 - j) * 64 + n], b = bb[n * 16 + q0 + e];
                v[e] = (row < 64) ? (w.x * b.x - w.y * b.y) : (w.x * b.y + w.y * b.x); } else v[e] = 0.f; }
        u32x4 o; o.x = cvt_pk_bf16(v[0], v[1]); o.y = cvt_pk_bf16(v[2], v[3]); o.z = cvt_pk_bf16(v[4], v[5]); o.w = cvt_pk_bf16(v[6], v[7]);
        *(u32x4*)(W1s + (size_t)row * 256 + k0) = o; }
    __syncthreads();
}

__device__ __forceinline__ int moe_build_tiles(gu32* counts, LAS int* tt, int tid) {
    LAS int* cnt = tt + 1400; LAS int* st = cnt + 32; LAS int* tb = st + 33;
    if (tid < 32) cnt[tid] = (int)__hip_atomic_load(counts + tid, RLX_AGENT);
    __syncthreads();
    if (tid == 0) { int s = 0, b = 0;
        for (int e = 0; e < 32; ++e) { const int n = cnt[e]; if (s < HSPLIT && s + n > HSPLIT) s += (HSPLIT - s) & 255; st[e] = s; tb[e] = b; s += n; b += (n + 255) >> 8; }
        st[32] = s; tb[32] = b; }
    __syncthreads();
    if (tid < 32) { const int n = cnt[tid], s = st[tid], b = tb[tid]; const int k = (n + 255) >> 8;
        for (int m = 0; m < k; ++m) { const int nr = (n - m * 256) < 256 ? (n - m * 256) : 256; tt[2 * (b + m)] = tid | (nr << 8); tt[2 * (b + m) + 1] = s + m * 256; } }
    __syncthreads();
    return tb[32];
}

struct DownConvHook {
    static constexpr bool ON = true; static constexpr int I_E = 8 * 32, NDOWN = 32 * I_E;
    const float* p_wd; unsigned char* ws; gu32* cnt; int cls;
    __device__ __forceinline__ void pair(int lane) const {
        int u0 = 0; if (lane == 0) u0 = (int)__hip_atomic_fetch_add(cnt, 2u, RLX_AGENT);
        u0 = __builtin_amdgcn_readfirstlane(u0); if (u0 >= NDOWN) return;
        const int e = u0 / I_E, q = u0 % I_E;
        const TrJob ja{p_wd + (size_t)e * 1048576, nullptr, (bf16_t*)(ws + WS_WDT + (size_t)e * 1024 * 1024), 1024, 1024, (q / 32) * 128, (q % 32) * 32, -1, 1};
        TrJob jb = ja; jb.n0 += 32;
        const f32x4 s32 = (f32x4){32.f, 32.f, 32.f, 32.f}; const f32x4 sc[4] = {s32, s32, s32, s32};
        f32x4 va[16], vb[16]; transpose8_load(ja, lane, va); transpose8_load(jb, lane, vb);
        transpose8_store_sc(ja, lane, va, sc); transpose8_store_sc(jb, lane, vb, sc); }
    __device__ __forceinline__ void operator()(int ui) const {
        if ((ui & 3) != cls) return;
        int lane_ = threadIdx.x; asm volatile("" : "+v"(lane_)); pair(lane_ & 63); }
};

template <int PHM>
__global__ void __launch_bounds__(NTHREADS, 2) mk_fwd(Args args) {
    extern __shared__ __attribute__((aligned(16))) unsigned char lds_raw[];
    LAS unsigned char* lds = (LAS unsigned char*)lds_raw;
    volatile LAS unsigned* MISC = (volatile LAS unsigned*)(lds + LDS_MISC);
    const int tid = threadIdx.x, lane = tid & 63, wave = __builtin_amdgcn_readfirstlane(tid >> 6);
    const int G = gridDim.x; int bx = blockIdx.x; int vcu = (G % 8 == 0) ? (bx % 8) * (G / 8) + bx / 8 : bx;
    bool xl_ok = false; unsigned xl_x = 0u;
    unsigned char* ws = args.ws;
#define ctl ((gu32*)(ws + WS_CTL))
    if (tid < 64) MISC[tid] = 0u;
    __syncthreads();
    if (MK_N_LAUNCHES == 1) (void)xcd_barrier_post((unsigned*)(ws + WS_CTL) + CW_BAR, (volatile LAS unsigned*)(lds + LDS_MISC) + 8);
#define GRID_BAR() do { if (MK_N_LAUNCHES == 1) { XcdBarrier bar_; bar_.bar = (unsigned*)(ws + WS_CTL) + CW_BAR; bar_.x = xb_xcc_id(); bar_.st = (volatile LAS unsigned*)(lds + LDS_MISC) + 8; xcd_barrier(bar_); } } while (0)
#define SEAM_BAR(k) do { if (xl_ok) xcd_local_barrier((unsigned*)(ws + WS_CTL) + CW_BAR, xl_x, (unsigned)(G / 8) * (unsigned)(k)); else GRID_BAR(); } while (0)
#define IN(k) ((PHM >> (k)) & 1)
#define Xin ((const float*)INP(0))
#define rs1 ((float*)(ws + WS_RS1))
#define rs2 ((float*)(ws + WS_RS2))
#define tope ((int*)(ws + WS_TOPE))
#define topg ((float*)(ws + WS_TOPG))
#define spos ((int*)(ws + WS_SPOS))
#define srow ((int*)(ws + WS_SROW))
#define rtok ((int*)(ws + WS_RTOK))
#define rgate ((float*)(ws + WS_RGATE))
#define rrs ((float*)(ws + WS_RRS))
#define XB ((bf16_t*)(ws + WS_H1B))
#define H1b ((bf16_t*)(ws + WS_H1B))
#define WinT ((bf16_t*)(ws + WS_WINT))
#define WgluT ((bf16_t*)(ws + WS_WGLUT))
#define WaT ((bf16_t*)(ws + WS_WAT))
#define WoT ((bf16_t*)(ws + WS_WOT))
#define Wm ((bf16_t*)(ws + WS_WM))
#define AS5 ((bf16_t*)(ws + WS_AS5))
#define Ub ((bf16_t*)(ws + WS_U))
#define Vb ((bf16_t*)(ws + WS_V))
#define Zb ((bf16_t*)(ws + WS_Z))
#define YAB ((bf16_t*)(ws + WS_YAB))
#define GA ((bf16_t*)args.out)
#define GB ((bf16_t*)args.out + (size_t)T * 1024)
#define SST ((float*)(ws + WS_SST))
#define MRG ((bf16_t*)(ws + WS_MRG))
#define gw (vcu * NWAVES + wave)
#define NGW (G * NWAVES)

    if (IN(0)) {
        if (vcu < 32) s5_build_group(args, vcu, lds, tid);
        constexpr int I_IN = 8 * 16 * INP_NF8, I_INB = 16 * 16 * INP_NBF, I_IN8 = 8 * 64, I_GLU = 8 * 16, I_A = 8 * 32, I_B = 8 * 32, I_O = 16 * 32, I_E = 8 * 32;
        constexpr int NSMALL = I_INB + I_GLU + I_A + I_B + I_O, NITEMS = NSMALL + I_IN8 + I_IN, NXU = T / 2;
        const float *p_win = INP(2), *p_g1 = INP(1), *p_glu = INP(11), *p_wa = INP(17), *p_wb = INP(18), *p_wo = INP(19), *p_x = INP(0);
        auto mkjob = [&](int r) -> TrJob { TrJob j; constexpr int f8g[4] = INP_F8_GROUPS, bfg[4] = INP_BF_GROUPS;
            if (r < I_INB) { const int n0 = (r % (16 * INP_NBF)) * 32, gc = bfg[n0 >> 9] * 512 + (n0 & 511); j = TrJob{p_win + (gc - n0), p_g1, (bf16_t*)(ws + WS_WINT + (4u << 20)), INW, 1024, (r / (16 * INP_NBF)) * 64, n0, -1, 0}; return j; } r -= I_INB;
            if (r < I_GLU) { j = TrJob{p_glu, nullptr, WgluT, 512, 512, (r / 16) * 64, (r % 16) * 32, -1, 0}; return j; } r -= I_GLU;
            if (r < I_A) { j = TrJob{p_wa, nullptr, WaT, 1024, 1024, (r / 32) * 64, (r % 32) * 32, -1, 0}; return j; } r -= I_A;
            if (r < I_B) { j = TrJob{p_wb, nullptr, WaT + 512, 1024, 1024, (r / 32) * 64, (r % 32) * 32, -1, 0}; return j; } r -= I_B;
            if (r < I_O) { j = TrJob{p_wo, nullptr, WoT, 1024, 1024, (r / 32) * 64, (r % 32) * 32, -1, 0}; return j; } r -= I_O;
            if (r < I_IN) { const int n0 = (r % (16 * INP_NF8)) * 32, gc = f8g[n0 >> 9] * 512 + (n0 & 511); j = TrJob{p_win + (gc - n0), p_g1, WinT, INW, 1024, (r / (16 * INP_NF8)) * 128, n0, -1, 1}; return j; } r -= I_IN;
            const int nb = r % 64; j = TrJob{p_win + (nb < 32 ? 1536 : 2560), p_g1, (bf16_t*)(ws + WS_WINT + (size_t)512 * INP_NF8 * 1024), INW, 1024, (r / 64) * 128, (nb & 31) * 32, nb < 32 ? 0 : 128, 1}; return j; };
        for (;;) {
            int u0 = 0; if (lane == 0) u0 = (int)__hip_atomic_fetch_add(ctl + CW_CNT + 64, 4u, RLX_AGENT);
            u0 = __builtin_amdgcn_readfirstlane(u0); if (u0 >= NITEMS) break;
            for (int p = 0; p < 4; p += 2) { const int i0 = u0 + p, i1 = i0 + 1;
                if (i0 < NSMALL) { const TrJob ja = mkjob(i0), jb = mkjob(i1); f32x4 va[8], vb[8]; transpose_load(ja, lane, va); transpose_load(jb, lane, vb); transpose_store(ja, lane, va); transpose_store(jb, lane, vb); }
                else { const TrJob ja = mkjob(i0), jb = mkjob(i1); f32x4 va[16], vb[16]; transpose8_load(ja, lane, va); transpose8_load(jb, lane, vb); transpose8_store(ja, lane, va); transpose8_store(jb, lane, vb); } }
        }
        for (;;) {
            int u0 = 0; if (lane == 0) u0 = (int)__hip_atomic_fetch_add(ctl + CW_CNT + 192, 8u, RLX_AGENT);
            u0 = __builtin_amdgcn_readfirstlane(u0); if (u0 >= NXU) break;
            for (int p = 0; p < 8; p += 2) { const int m = (p >> 1) * (T / 4) + (u0 >> 1);
                const f32x4* xr = (const f32x4*)(p_x + (size_t)m * D) + 2 * lane; f32x4 v[16]; float s[4] = {0.f, 0.f, 0.f, 0.f};
#pragma unroll
                for (int q = 0; q < 4; ++q)
#pragma unroll
                    for (int j = 0; j < 2; ++j) { v[4 * q + 2 * j] = __builtin_nontemporal_load(xr + 256 * q + 128 * j); v[4 * q + 2 * j + 1] = __builtin_nontemporal_load(xr + 256 * q + 128 * j + 1); }
#pragma unroll
                for (int q = 0; q < 4; ++q)
#pragma unroll
                    for (int j = 0; j < 4; ++j) { const f32x4 w = v[4 * q + j]; s[q] += (w.x * w.x + w.y * w.y) + (w.z * w.z + w.w * w.w); }
#pragma unroll
                for (int o = 1; o < 64; o <<= 1) { s[0] += __shfl_xor(s[0], o); s[1] += __shfl_xor(s[1], o); s[2] += __shfl_xor(s[2], o); s[3] += __shfl_xor(s[3], o); }
                if (lane < 4) { const float sv = lane == 0 ? s[0] : (lane == 1 ? s[1] : (lane == 2 ? s[2] : s[3])); rs1[m + lane] = 1.0f / sqrtf(sv * (1.0f / D) + NORM_EPS); }
                u32x4* o = (u32x4*)(XB + (size_t)m * D) + lane; u32x2* o8 = (u32x2*)(ws + WS_H1F8 + (size_t)m * D) + lane;
#pragma unroll
                for (int q = 0; q < 4; ++q)
#pragma unroll
                    for (int j = 0; j < 2; ++j) { const f32x4 w0 = v[4 * q + 2 * j], w1 = v[4 * q + 2 * j + 1]; o[128 * q + 64 * j] = pack8(w0, w1); o8[128 * q + 64 * j] = pack8_f8(w0, w1); } }
        }
        { const float* bgp = INP(24); const float* bup_ = INP(26); const float* bdp = INP(28); const float* blp = INP(12);
          for (int i = vcu * NTHREADS + tid; i < 32768; i += G * NTHREADS) { ((float*)(ws + WS_BG))[i] = bgp[i] * MOE_KSG; ((float*)(ws + WS_BU))[i] = (bup_[i] + 1.0f) * (1.0f / MOE_KSG); ((float*)(ws + WS_BD))[i] = bdp[i]; if (i < 512) ((float*)(ws + WS_BGLU))[i] = blp[i];
              if (i < 16384) { const int kp = i >> 5, e = i & 31; const float* wr_ = INP(21); const float* g2 = INP(20); const float w0 = wr_[(2 * kp) * 32 + e] * g2[2 * kp], w1 = wr_[(2 * kp + 1) * 32 + e] * g2[2 * kp + 1];
                  const unsigned hi = cvt_pk_bf16(w0, w1); const unsigned lo = cvt_pk_bf16(w0 - bflo(hi), w1 - bfhi(hi));
                  *(unsigned*)(ws + WS_WRIMG + e * 2064 + 4 * kp) = hi; *(unsigned*)(ws + WS_WRIMG + 32 * 2064 + e * 2064 + 4 * kp) = lo; }
              if (i < 1024) { const float g2v = INP(20)[i]; ((float*)(ws + WS_G2S))[i] = g2v * MOE_KSG; ((float*)(ws + WS_G2S))[1024 + i] = g2v * (1.0f / MOE_KSG); } } }
        for (int i = vcu * NTHREADS + tid; i < 4 * 128 * 128; i += G * NTHREADS) { const int ii = (i >> 7) & 127, jj = i & 127; const float w = ((ii >> 6) >= (jj >> 6)) ? INP(15)[i] : 0.f; Wm[i] = (bf16_t)(cvt_pk_bf16(w, 0.f) & 0xffffu); }
        GRID_BAR();
        if (MK_N_LAUNCHES == 1 && __builtin_amdgcn_readfirstlane((int)MISC[10]) != 0) {
            xl_ok = true; xl_x = xb_xcc_id(); const int rk = __builtin_amdgcn_readfirstlane((int)MISC[11]);
            bx = rk * 8 + (int)xl_x; vcu = (int)xl_x * (G / 8) + rk; }
    }

    if (IN(1)) {
        constexpr int f8g[4] = INP_F8_GROUPS, bfg[4] = INP_BF_GROUPS;
        constexpr int I_E = 8 * 32, NMOE = 64 * I_E, GRABM = 4, QUOTA = 2;
        const int cls = (G == 256) ? ((bx >> 3) & 3) : 3;
#pragma unroll 1
        for (int stage = 0; stage < 4; ++stage) {
            const int quota = stage == 3 ? (1 << 30) : (stage == cls ? QUOTA : 0);
            if (quota > 0) { int lane_ = threadIdx.x; asm volatile("" : "+v"(lane_)); const int lane = lane_ & 63;
        const float *p_g2 = (const float*)(ws + WS_G2S), *p_wg = INP(23), *p_wu = INP(25), *p_wd = INP(27);
            auto mkmoe = [&](int r) -> TrJob { TrJob j; const int ty = r / (32 * I_E), e = (r / I_E) % 32, q = r % I_E, k0 = (q / 32) * 128, n0 = (q % 32) * 32;
                if (ty == 0) j = TrJob{p_wg + (size_t)e * 1048576, p_g2, (bf16_t*)(ws + WS_W1T + (size_t)e * 2048 * 1024), 1024, 1024, k0, n0, 0, 1};
                else if (ty == 1) j = TrJob{p_wu + (size_t)e * 1048576, p_g2 + 1024, (bf16_t*)(ws + WS_W1T + (size_t)e * 2048 * 1024), 1024, 1024, k0, n0, 128, 1};
                else j = TrJob{p_wd + (size_t)e * 1048576, nullptr, (bf16_t*)(ws + WS_WDT + (size_t)e * 1024 * 1024), 1024, 1024, k0, n0, -1, 1};
                return j; };
            for (int gq = 0; gq < quota; ++gq) {
                int u0 = 0; if (lane == 0) u0 = (int)__hip_atomic_fetch_add(ctl + CW_CNT + 128, (unsigned)GRABM, RLX_AGENT);
                u0 = __builtin_amdgcn_readfirstlane(u0); if (u0 >= NMOE) break;
                const TrJob j0 = mkmoe(u0); f32x4 sc[4];
#pragma unroll
                for (int q = 0; q < 4; ++q) sc[q] = (j0.ks ? *(const f32x4*)(j0.ks + j0.k0 + 16 * (lane >> 3) + 4 * q) : (f32x4){1.f, 1.f, 1.f, 1.f}) * 32.0f;
                for (int p = 0; p < GRABM; p += 2) { const TrJob ja = mkmoe(u0 + p), jb = mkmoe(u0 + p + 1); f32x4 va[16], vb[16]; transpose8_load(ja, lane, va); transpose8_load(jb, lane, vb);
                    transpose8_store_sc(ja, lane, va, sc); transpose8_store_sc(jb, lane, vb, sc); } } }
            __syncthreads();
            if (stage == 0) { if (INP_NBF > 0) { pg8::DenseSched S; S.init(WS_H1B, WS_WINT + (4u << 20), T, 512 * INP_NBF, D, D, G, bx);
                int pm_ = 0; for (int q = 0; q < 2 * INP_NBF; ++q) pm_ |= (2 * bfg[q >> 1] + (q & 1)) << (4 * q);
                pg8::EpiInProj E{AS5, Ub, Vb, pm_, 1.0f};
                pg8::gemm_phase(lds, ws, S, E); } }
            else if (stage <= 2) { pg8::DenseSchedT<true> S; S.init(WS_H1F8, WS_WINT, T / 2, 512 * INP_NF8 + 2048, D, D, G, bx); S.pm0 = (T / 512) * (stage - 1);
                int pm_ = 0; for (int q = 0; q < 2 * INP_NF8; ++q) pm_ |= (2 * f8g[q >> 1] + (q & 1)) << (4 * q);
                pg8::EpiInProjGates E{pg8::EpiInProj{AS5, Ub, Vb, pm_, 0.03125f}, pg8::EpiGates{GA, GB}, 2 * INP_NF8};
                pg8::gemm_phase(lds, ws, S, E); }
        }
        GRID_BAR();
    }

    if (IN(2)) {
        { pg8::S5Sched S; S.init(WS_AS5, WS_W1S, 256, vcu); pg8::EpiS5End E{SST}; pg8::gemm_phase(lds, ws, S, E); }

        for (int item = vcu; item < 256; item += G) {
            const int t0 = item * 128; constexpr int RS = 1056;
            const float* lng = INP(13); const float* lnb = INP(14); const float* bs = INP(16);
            const f32x4 g0 = *(const f32x4*)(lng + lane * 8), g1 = *(const f32x4*)(lng + lane * 8 + 4), b0 = *(const f32x4*)(lnb + lane * 8), b1 = *(const f32x4*)(lnb + lane * 8 + 4);
            u32x4 raw[16]; float sm[16], sq[16];
#pragma unroll
            for (int r = 0; r < 16; ++r) raw[r] = *(const u32x4*)(Vb + (size_t)(t0 + wave * 16 + r) * 512 + lane * 8);
#pragma unroll
            for (int r = 0; r < 16; ++r) { f32x4 v0, v1; unpack8(raw[r], v0, v1); sm[r] = (v0[0] + v0[1]) + (v0[2] + v0[3]) + (v1[0] + v1[1]) + (v1[2] + v1[3]); }
#pragma unroll
            for (int o = 1; o < 64; o <<= 1)
#pragma unroll
                for (int r = 0; r < 16; ++r) sm[r] += __shfl_xor(sm[r], o);
#pragma unroll
            for (int r = 0; r < 16; ++r) { f32x4 v0, v1; unpack8(raw[r], v0, v1); const float mean = sm[r] * (1.0f / 512.0f); v0 -= mean; v1 -= mean;
                sq[r] = (v0[0] * v0[0] + v0[1] * v0[1]) + (v0[2] * v0[2] + v0[3] * v0[3]) + (v1[0] * v1[0] + v1[1] * v1[1]) + (v1[2] * v1[2] + v1[3] * v1[3]); }
#pragma unroll
            for (int o = 1; o < 64; o <<= 1)
#pragma unroll
                for (int r = 0; r < 16; ++r) sq[r] += __shfl_xor(sq[r], o);
#pragma unroll
            for (int r = 0; r < 16; ++r) { f32x4 v0, v1; unpack8(raw[r], v0, v1); const float mean = sm[r] * (1.0f / 512.0f), rstd = 1.0f / sqrtf(sq[r] * (1.0f / 512.0f) + NORM_EPS);
                v0 = (v0 - mean) * rstd * g0 + b0; v1 = (v1 - mean) * rstd * g1 + b1;
                *(LAS u32x4*)(lds + (wave * 16 + r) * RS + lane * 16) = pack8(v0, v1); }
            __syncthreads();
            const int i0 = wave * 16, fr = lane & 15, fq = lane >> 4;
            bf16x8 wf[4], wn[4]; u32x4 uf[4], un[4];
            const bf16_t* urow = Ub + (size_t)(t0 + i0 + fr) * 512 + (fq & 1) * 16 + 8 * (fq >> 1);
#pragma unroll
            for (int ks = 0; ks < 4; ++ks) wf[ks] = *(const bf16x8*)(Wm + ((size_t)0 * 128 + i0 + fr) * 128 + ks * 32 + fq * 8);
#pragma unroll
            for (int j = 0; j < 4; ++j) uf[j] = *(const u32x4*)(urow + j * 32);
            for (int h = 0; h < 4; ++h) {
                const int hn = h < 3 ? h + 1 : 3;
#pragma unroll
                for (int ks = 0; ks < 4; ++ks) wn[ks] = *(const bf16x8*)(Wm + ((size_t)hn * 128 + i0 + fr) * 128 + ks * 32 + fq * 8);
#pragma unroll
                for (int j = 0; j < 4; ++j) un[j] = *(const u32x4*)(urow + hn * 128 + j * 32);
                const float bias = bs[h * 128 + i0 + fr];
#pragma unroll
                for (int j = 0; j < 4; ++j) { u32x2 o2[2];
                    const auto s0 = __builtin_amdgcn_permlane16_swap(uf[j].x, uf[j].z, false, false), s1 = __builtin_amdgcn_permlane16_swap(uf[j].y, uf[j].w, false, false);
                    const u32x2 uw2[2] = {(u32x2){s0[0], s1[0]}, (u32x2){s0[1], s1[1]}};
#pragma unroll
                    for (int q = 0; q < 2; ++q) { const int cb = 2 * j + q; f32x4 a = (f32x4){0.f, 0.f, 0.f, 0.f}; const int c0 = h * 128 + cb * 16;
#pragma unroll
                        for (int ks = 0; ks < 4; ++ks) {
                            const LAS unsigned char* p = lds + (ks * 32 + fq * 8 + (fr >> 2)) * RS + (c0 + 4 * (fr & 3)) * 2;
                            const s16x4 lo4 = __builtin_bit_cast(s16x4, __builtin_amdgcn_ds_read_tr16_b64_v4i16((LAS s16x4*)p));
                            const s16x4 hi4 = __builtin_bit_cast(s16x4, __builtin_amdgcn_ds_read_tr16_b64_v4i16((LAS s16x4*)(p + 4 * RS)));
                            const bf16x8 vf = (bf16x8){lo4[0], lo4[1], lo4[2], lo4[3], hi4[0], hi4[1], hi4[2], hi4[3]};
                            a = __builtin_amdgcn_mfma_f32_16x16x32_bf16(vf, wf[ks], a, 0, 0, 0); }
                        o2[q].x = cvt_pk_bf16(bflo(uw2[q].x) * (a[0] + bias), bfhi(uw2[q].x) * (a[1] + bias)); o2[q].y = cvt_pk_bf16(bflo(uw2[q].y) * (a[2] + bias), bfhi(uw2[q].y) * (a[3] + bias)); }
                    *(u32x4*)(YAB + (size_t)(t0 + i0 + fr) * 1024 + 512 + h * 128 + (2 * j + (fq & 1)) * 16 + 8 * (fq >> 1)) = pair16_f8(o2[0], o2[1]); }
#pragma unroll
                for (int ks = 0; ks < 4; ++ks) wf[ks] = wn[ks];
#pragma unroll
                for (int j = 0; j < 4; ++j) uf[j] = un[j];
            }
            __syncthreads();
        }

        SEAM_BAR(1);
    }

    if (IN(3)) {
        for (int item = vcu; item < 256; item += G) {
            const int g = item >> 3, b = (item >> 1) & 3, nh = item & 1;
            LAS float* sm = (LAS float*)lds;
            LAS f32x2* Eb = (LAS f32x2*)(lds + 131072);
            { f32x4 t[16];
#pragma unroll
              for (int j = 0; j < 16; ++j) { const int i = tid + j * NTHREADS, c = i >> 4, part = (i >> 3) & 1, q = i & 7; t[j] = *(const f32x4*)(SST + (size_t)(b * 512 + c) * 4096 + g * 128 + part * 64 + nh * 32 + q * 4); }
#pragma unroll
              for (int j = 0; j < 16; ++j) { const int i = tid + j * NTHREADS, c = i >> 4, part = (i >> 3) & 1, q = i & 7; *(LAS f32x4*)(sm + c * 64 + part * 32 + q * 4) = t[j]; } }
            __syncthreads();
            const int seg = tid >> 5, nl = tid & 31, n = nh * 32 + nl; const f32x2* lamtab = (const f32x2*)(ws + WS_LAM);
            const f32x2 l16 = lamtab[g * 64 + n], l512 = lamtab[2048 + g * 64 + n];
            float sr = 0.f, si = 0.f;
            for (int c = seg * 32; c < seg * 32 + 32; ++c) { const float xr = sm[c * 64 + nl], xi = sm[c * 64 + 32 + nl]; const float tr = l16.x * sr - l16.y * si + xr, ti = l16.x * si + l16.y * sr + xi; sr = tr; si = ti; }
            Eb[seg * 32 + nl] = (f32x2){sr, si};
            __syncthreads();
            sr = 0.f; si = 0.f;
            for (int s = 0; s < seg; ++s) { const f32x2 e = Eb[s * 32 + nl]; const float tr = l512.x * sr - l512.y * si + e.x, ti = l512.x * si + l512.y * sr + e.y; sr = tr; si = ti; }
            for (int c = seg * 32; c < seg * 32 + 32; ++c) {
                const float xr = sm[c * 64 + nl], xi = sm[c * 64 + 32 + nl]; sm[c * 64 + nl] = sr; sm[c * 64 + 32 + nl] = si;
                const float tr = l16.x * sr - l16.y * si + xr, ti = l16.x * si + l16.y * sr + xi; sr = tr; si = ti; }
            __syncthreads();
            { bf16_t* dst = AS5 + ((size_t)g * 2048 + (size_t)b * 512) * AS5_LD + 256 + nh * 32;
#pragma unroll
              for (int j = 0; j < 8; ++j) { const int p = tid + j * NTHREADS, c = p >> 3, sub = p & 7; const LAS float* sp = sm + c * 64 + (sub >> 2) * 32 + (sub & 3) * 8;
                  *(u32x4*)(dst + (size_t)c * AS5_LD + (sub >> 2) * 64 + (sub & 3) * 8) = pack8(*(const LAS f32x4*)sp, *(const LAS f32x4*)(sp + 4)); } }
            __syncthreads();
        }
        SEAM_BAR(2);
    }

    if (IN(4)) {
        pg8::S5Sched S; S.init(WS_AS5, WS_MT, 384, vcu); pg8::EpiS5Out E{Zb}; pg8::gemm_phase(lds, ws, S, E);
        GRID_BAR();
    }
    if (IN(5)) {
        pg8::DenseSched S; S.init(WS_Z, WS_WGLUT, T, 512, 512, 512, G, bx); pg8::EpiGlu E{Zb, INP(12), YAB}; pg8::gemm_phase(lds, ws, S, E);
        SEAM_BAR(3);
    }
    if (IN(6)) {
        pg8::DenseSched S; S.init(WS_YAB, WS_WAT, T, D, D, D, G, bx); pg8::EpiMerge E{GA, GB, MRG}; pg8::gemm_phase(lds, ws, S, E);
        SEAM_BAR(4);
    }
    if (IN(7)) {
        pg8::DenseSched S; S.init(WS_MRG, WS_WOT, T, D, D, D, G, bx); pg8::EpiOutProj E{H1b, ws + WS_H1F8}; pg8::gemm_phase(lds, ws, S, E);
        SEAM_BAR(5);
    }
    if (IN(8)) {
        constexpr int WRS = 2064;
        LAS unsigned char* WRhi = lds; LAS unsigned char* WRlo = lds + 32 * WRS;
        LAS int* hist = (LAS int*)(lds + LDS_X + 20480); LAS int* hbase = hist + 32;
        { const u32x4* img = (const u32x4*)(ws + WS_WRIMG) + tid; u32x4 t[16], tl = (u32x4){0u, 0u, 0u, 0u};
#pragma unroll
          for (int j = 0; j < 16; ++j) t[j] = img[j * NTHREADS];
          if (tid < 132096 / 16 - 16 * NTHREADS) tl = img[16 * NTHREADS];
#pragma unroll
          for (int j = 0; j < 16; ++j) *(LAS u32x4*)(lds + (tid + j * NTHREADS) * 16) = t[j];
          if (tid < 132096 / 16 - 16 * NTHREADS) *(LAS u32x4*)(lds + (tid + 16 * NTHREADS) * 16) = tl; }
        if (tid < 32) hist[tid] = 0;
        __syncthreads();
        const float* brt = INP(22);
        for (int blk = vcu; blk < 256; blk += G) {
            int e4[4] = {0, 0, 0, 0}, lp4[4] = {0, 0, 0, 0}; float gt4[4] = {0.f, 0.f, 0.f, 0.f}, rsv = 0.f; const int tok0 = blk * 128 + wave * 32; const int hi = lane >> 5, li = lane & 31;
            if (wave < 4) {
                LAS float* scr = (LAS float*)(lds + 132096 + wave * 4608);
                const bf16_t* hrow = H1b + (size_t)(tok0 + li) * 1024 + 8 * hi;
                const LAS unsigned char* bh = WRhi + li * WRS + 16 * hi; const LAS unsigned char* bl = WRlo + li * WRS + 16 * hi;
                f32x16 acc; for (int r = 0; r < 16; ++r) acc[r] = 0.f; float ssq = 0.f;
#pragma unroll 8
                for (int s = 0; s < 64; ++s) { const u32x4 av = *(const u32x4*)(hrow + 16 * s);
                    ssq += (bflo(av.x) * bflo(av.x) + bfhi(av.x) * bfhi(av.x)) + (bflo(av.y) * bflo(av.y) + bfhi(av.y) * bfhi(av.y)) + (bflo(av.z) * bflo(av.z) + bfhi(av.z) * bfhi(av.z)) + (bflo(av.w) * bflo(av.w) + bfhi(av.w) * bfhi(av.w));
                    const bf16x8 a = __builtin_bit_cast(bf16x8, av);
                    acc = __builtin_amdgcn_mfma_f32_32x32x16_bf16(a, *(const LAS bf16x8*)(bh + 32 * s), acc, 0, 0, 0);
                    acc = __builtin_amdgcn_mfma_f32_32x32x16_bf16(a, *(const LAS bf16x8*)(bl + 32 * s), acc, 0, 0, 0); }
                ssq += __shfl_xor(ssq, 32);
#pragma unroll
                for (int r = 0; r < 16; ++r) scr[((r & 3) + 8 * (r >> 2) + 4 * hi) * 33 + li] = acc[r];
                LDS_WAIT(); asm volatile("" ::: "memory");
                if (lane < 32) { const float rs = 1.0f / sqrtf(ssq * (1.0f / 1024.0f) + NORM_EPS); rsv = rs;
                    float v4[4]; int i0 = -1, i1 = -1, i2 = -1;
#pragma unroll
                    for (int k = 0; k < 4; ++k) { float best = -INFINITY; int bi = 0;
                        for (int e = 0; e < 32; ++e) { const float l = scr[lane * 33 + e] * rs + brt[e]; const bool ok = (e != i0) && (e != i1) && (e != i2); if (ok && l > best) { best = l; bi = e; } }
                        v4[k] = best; e4[k] = bi; if (k == 0) i0 = bi; else if (k == 1) i1 = bi; else if (k == 2) i2 = bi; }
                    const float p1 = __expf(v4[1] - v4[0]), p2 = __expf(v4[2] - v4[0]), p3 = __expf(v4[3] - v4[0]); const float inv = 1.0f / (1.0f + p1 + p2 + p3);
                    gt4[0] = inv; gt4[1] = p1 * inv; gt4[2] = p2 * inv; gt4[3] = p3 * inv;
#pragma unroll
                    for (int k = 0; k < 4; ++k) lp4[k] = __hip_atomic_fetch_add((int*)(hist + e4[k]), 1, __ATOMIC_RELAXED, __HIP_MEMORY_SCOPE_WORKGROUP); }
            }
            __syncthreads();
            if (tid < 32) { const int c = hist[tid]; hbase[tid] = c ? (int)__hip_atomic_fetch_add(ctl + CW_CNT + tid, (unsigned)c, RLX_AGENT) : 0; hist[tid] = 0; }
            __syncthreads();
            if (wave < 4 && lane < 32) { const int t = tok0 + lane;
#pragma unroll
                for (int k = 0; k < 4; ++k) { const int pos = hbase[e4[k]] + lp4[k], ix = e4[k] * T + pos; lp4[k] = pos;
                    ((int*)(ws + WS_RT2))[ix] = t; ((float*)(ws + WS_RG2))[ix] = gt4[k]; ((float*)(ws + WS_RR2))[ix] = rsv; }
                *(int4*)(tope + t * 4) = make_int4(e4[0], e4[1], e4[2], e4[3]); *(int4*)(spos + t * 4) = make_int4(lp4[0], lp4[1], lp4[2], lp4[3]); }
            __syncthreads();
        }
        GRID_BAR();
    }
    if (IN(10)) {
        LAS int* tt = (LAS int*)(lds + LDS_X); const int ntiles = moe_build_tiles(ctl + CW_CNT, tt, tid);
        pg8::MoeSched1 S; S.A = (unsigned)WS_H1F8; S.Bt = (unsigned)WS_W1T; S.rtk = (const int*)(ws + WS_RT2); S.tt = tt; S.lda2 = 1024u; S.K2 = 1024u; S.hstepA = 0u; S.nt = 8; S.ntiles = ntiles; S.G = G; S.vc = vcu;
        pg8::EpiMoe1 E{rrs, INP(24), INP(26), ws + WS_HWS, ws + WS_TRASH};
        const DownConvHook H{INP(27), ws, ctl + CW_CNT + 160, (vcu >> 3) & 3};
        pg8::gemm_phase(lds, ws, S, E, H);
        { int lane_ = threadIdx.x; asm volatile("" : "+v"(lane_)); const int ln = lane_ & 63;
          while (__hip_atomic_load(ctl + CW_CNT + 160, RLX_AGENT) < (unsigned)DownConvHook::NDOWN) H.pair(ln); }
        GRID_BAR();
    }
    if (IN(11)) {
        LAS int* tt = (LAS int*)(lds + LDS_X); const int ntiles = moe_build_tiles(ctl + CW_CNT, tt, tid);
        pg8::MoeSched2 S; S.Ahi = (unsigned)WS_HWS; S.Bt = (unsigned)WS_WDT; S.tt = tt; S.lda2 = 1024u; S.K2 = 1024u; S.hstepA = 128u * 1024u; S.nt = 8; S.ntiles = ntiles; S.G = G; S.vc = vcu;
        pg8::EpiMoe2 E{rgate, INP(28), ws + WS_Y, ws + WS_TRASH}; pg8::gemm_phase(lds, ws, S, E);
        GRID_BAR();
    }
    if (IN(12)) {
        LAS int* ttf = (LAS int*)(lds + LDS_X); (void)moe_build_tiles(ctl + CW_CNT, ttf, tid); const LAS int* st = ttf + 1432;
        const float* gf = INP(29);
        const f32x4 gf0 = *(const f32x4*)(gf + lane * 8), gf1 = *(const f32x4*)(gf + lane * 8 + 4), gf2 = *(const f32x4*)(gf + 512 + lane * 8), gf3 = *(const f32x4*)(gf + 512 + lane * 8 + 4);
        u32x4 cur[2], nxt[2]; u32x2 ycur[8], ynxt[8];
#define P12_LOAD(dst, ydst, tt) do { const int4 te_ = *(const int4*)(tope + (size_t)(tt) * 4), sp_ = *(const int4*)(spos + (size_t)(tt) * 4); const int r0_ = __builtin_amdgcn_readfirstlane(st[te_.x] + sp_.x), r1_ = __builtin_amdgcn_readfirstlane(st[te_.y] + sp_.y), r2_ = __builtin_amdgcn_readfirstlane(st[te_.z] + sp_.z), r3_ = __builtin_amdgcn_readfirstlane(st[te_.w] + sp_.w); \
            const unsigned char* Y8_ = ws + WS_Y + lane * 8; \
            dst[0] = __builtin_nontemporal_load((const u32x4*)(H1b + (size_t)(tt) * 1024 + lane * 8)); dst[1] = __builtin_nontemporal_load((const u32x4*)(H1b + (size_t)(tt) * 1024 + 512 + lane * 8)); \
            ydst[0] = __builtin_nontemporal_load((const u32x2*)(Y8_ + (size_t)r0_ * 1024)); ydst[1] = __builtin_nontemporal_load((const u32x2*)(Y8_ + (size_t)r0_ * 1024 + 512)); \
            ydst[2] = __builtin_nontemporal_load((const u32x2*)(Y8_ + (size_t)r1_ * 1024)); ydst[3] = __builtin_nontemporal_load((const u32x2*)(Y8_ + (size_t)r1_ * 1024 + 512)); \
            ydst[4] = __builtin_nontemporal_load((const u32x2*)(Y8_ + (size_t)r2_ * 1024)); ydst[5] = __builtin_nontemporal_load((const u32x2*)(Y8_ + (size_t)r2_ * 1024 + 512)); \
            ydst[6] = __builtin_nontemporal_load((const u32x2*)(Y8_ + (size_t)r3_ * 1024)); ydst[7] = __builtin_nontemporal_load((const u32x2*)(Y8_ + (size_t)r3_ * 1024 + 512)); } while (0)
#define P12_ADD8(w, lo4, hi4) do { const f32x2 q0_ = __builtin_amdgcn_cvt_pk_f32_fp8((int)(w).x, false), q1_ = __builtin_amdgcn_cvt_pk_f32_fp8((int)(w).x, true), q2_ = __builtin_amdgcn_cvt_pk_f32_fp8((int)(w).y, false), q3_ = __builtin_amdgcn_cvt_pk_f32_fp8((int)(w).y, true); \
            lo4 += (f32x4){q0_.x, q0_.y, q1_.x, q1_.y} * 0.0625f; hi4 += (f32x4){q2_.x, q2_.y, q3_.x, q3_.y} * 0.0625f; } while (0)
        int t = gw;
        if (t < T) P12_LOAD(cur, ycur, t);
        for (; t < T; t += NGW) {
            const int tn = t + NGW; const bool hn = tn < T;
            if (hn) P12_LOAD(nxt, ynxt, tn);
            f32x4 a0, a1, a2, a3; unpack8(cur[0], a0, a1); unpack8(cur[1], a2, a3);
#pragma unroll
            for (int k = 0; k < 4; ++k) { P12_ADD8(ycur[2 * k], a0, a1); P12_ADD8(ycur[2 * k + 1], a2, a3); }
            float s = 0.f;
#pragma unroll
            for (int j = 0; j < 4; ++j) s += a0[j] * a0[j] + a1[j] * a1[j] + a2[j] * a2[j] + a3[j] * a3[j];
            const float rs = 1.0f / sqrtf(wave_sum(s) * (1.0f / 1024.0f) + NORM_EPS);
            float* o = args.out + (size_t)t * 1024 + lane * 8;
            __builtin_nontemporal_store(a0 * rs * gf0, (f32x4*)o); __builtin_nontemporal_store(a1 * rs * gf1, (f32x4*)(o + 4)); __builtin_nontemporal_store(a2 * rs * gf2, (f32x4*)(o + 512)); __builtin_nontemporal_store(a3 * rs * gf3, (f32x4*)(o + 516));
            if (hn) { cur[0] = nxt[0]; cur[1] = nxt[1];
#pragma unroll
                for (int i = 0; i < 8; ++i) ycur[i] = ynxt[i]; }
        }
#undef P12_ADD8
#undef P12_LOAD
    }
#undef IN
#undef GRID_BAR
}

typedef void (*kern_t)(Args);
template <int P> static void get_kerns(kern_t* k) { k[P] = mk_fwd<(1 << P)>; if constexpr (P > 0) get_kerns<P - 1>(k); }
extern "C" void kernel_launch(void* const* d_in, const int* in_sizes, int n_in, void* d_out, int out_size, void* d_ws, size_t ws_size, hipStream_t stream) {
    static int grid = 0; static kern_t kerns[NPHASE + 1];
    if (grid == 0) {
        if (n_in != 30 || in_sizes[0] != T * D || out_size != T * D || ws_size < WS_END) { fprintf(stderr, "kernel_launch: unexpected shapes / workspace (n_in %d, ws %zu)\n", n_in, ws_size); grid = -1; return; }
        int dev = 0, cus = 0, per_cu = 0;
        if (hipGetDevice(&dev) != hipSuccess || hipDeviceGetAttribute(&cus, hipDeviceAttributeMultiprocessorCount, dev) != hipSuccess) { grid = -1; return; }
#ifdef ONLY_PH
        kerns[ONLY_PH] = mk_fwd<(1 << ONLY_PH)>;
#else
        if constexpr (MK_N_LAUNCHES == 1) kerns[NPHASE] = mk_fwd<(1 << NPHASE) - 1>; else get_kerns<NPHASE - 1>(kerns);
#endif
        for (int p = 0; p <= NPHASE; ++p) if (kerns[p]) {
            if (hipFuncSetAttribute((const void*)kerns[p], hipFuncAttributeMaxDynamicSharedMemorySize, LDS_BYTES) != hipSuccess) { fprintf(stderr, "kernel_launch: hipFuncSetAttribute failed\n"); grid = -1; return; }
            if (hipOccupancyMaxActiveBlocksPerMultiprocessor(&per_cu, (const void*)kerns[p], NTHREADS, LDS_BYTES) != hipSuccess || per_cu < 1) { fprintf(stderr, "kernel_launch: occupancy query reports %d for kernel %d\n", per_cu, p); } }
        (void)hipGetLastError();
        grid = cus;
    }
    if (grid < 0) return;
    (void)hipMemsetAsync((char*)d_ws + WS_CTL, 0, CTL_ZERO_BYTES, stream);
    Args a{};
    for (int i = 0; i < 30; ++i) a.in[i] = (const float*)d_in[i];
    a.out = (float*)d_out; a.ws = (unsigned char*)d_ws;
    if (MK_N_LAUNCHES == 1) { a.ph_lo = 0; a.ph_hi = NPHASE; hipLaunchKernelGGL(kerns[NPHASE], dim3(grid), dim3(NTHREADS), LDS_BYTES, stream, a); }
    else for (int p = 0; p < NPHASE; ++p) { a.ph_lo = p; a.ph_hi = p + 1; hipLaunchKernelGGL(kerns[p], dim3(grid), dim3(NTHREADS), LDS_BYTES, stream, a); }
}
```
